# Optimizing an MI355X kernel written in HIP

```python
import jax, jax.numpy as jnp
from jax import lax
import numpy as np


D_MODEL = 1024
BATCH = 8
SEQ = 4096
DEPTH = 2

N_HEADS_ATTN = 8
HEAD_DIM = 64
ATTN_WIDTH = N_HEADS_ATTN * HEAD_DIM
ROPE_DIM = HEAD_DIM // 4
ROPE_THETA = 500000.0
IDX_HEADS = 8
IDX_DIM = 64
IDX_ROPE_DIM = IDX_DIM // 4
INDEX_TOPK = 256
Q_BLOCK = 64
LRU_WIDTH = 512
LRU_BLOCKS = 8
LRU_BLOCK_DIM = LRU_WIDTH // LRU_BLOCKS
CONV_WIDTH = 4
LRU_C = 8.0
GMLP_WIDTH = 512
GMLP_GROUPS = 8
GMLP_GROUP_DIM = GMLP_WIDTH // GMLP_GROUPS
CHUNK = 128
N_BRANCH = 3
BRANCH_WIDTH = 512
FFN_DIM = 4 * D_MODEL
PLE_DIM = 256
EPS = 1e-6

IN_SPLITS = (ATTN_WIDTH, ATTN_WIDTH, ATTN_WIDTH, IDX_HEADS * IDX_DIM, IDX_DIM, IDX_HEADS,
             LRU_WIDTH, LRU_WIDTH, GMLP_WIDTH, GMLP_WIDTH, N_BRANCH * D_MODEL)
IN_WIDTH = sum(IN_SPLITS)

kernel_name = 'hybrid_dsa_rglru_gmlp_block'


def rms_norm(x, g):
    xf = x.astype(jnp.float32)
    y = xf * lax.rsqrt(jnp.mean(xf * xf, axis=-1, keepdims=True) + EPS)
    return (y * g.astype(jnp.float32)).astype(x.dtype)


def apply_partial_rope(x, positions, rot_dim):
    half = rot_dim // 2
    inv_freq = ROPE_THETA ** (-jnp.arange(half, dtype=jnp.float32) * 2.0 / rot_dim)
    ang = positions.astype(jnp.float32)[..., None] * inv_freq
    cos = jnp.cos(ang)[:, :, None, :].astype(x.dtype)
    sin = jnp.sin(ang)[:, :, None, :].astype(x.dtype)
    x1 = x[..., :half]
    x2 = x[..., half:rot_dim]
    return jnp.concatenate([x1 * cos - x2 * sin, x2 * cos + x1 * sin, x[..., rot_dim:]], axis=-1)


def dsa_attention(q, k, v, qi, ki, wi):
    B, L = q.shape[0], q.shape[1]
    top_k = min(INDEX_TOPK, L // 4)
    nb = L // Q_BLOCK
    key_pos = jnp.arange(L)
    attn_scale = HEAD_DIM ** -0.5
    idx_scale = (IDX_DIM ** -0.5) * (IDX_HEADS ** -0.5)
    ki32 = ki.astype(jnp.float32)

    def to_blocks(a):
        return jnp.moveaxis(a.reshape((B, nb, Q_BLOCK) + a.shape[2:]), 1, 0)

    def one_block(args):
        qb, qib, wib, qpos = args
        dots = jnp.einsum('bqhd,bsd->bqhs', qib.astype(jnp.float32), ki32)
        score = jnp.einsum('bqh,bqhs->bqs', wib.astype(jnp.float32), jax.nn.relu(dots)) * idx_scale
        causal = key_pos[None, :] <= qpos[:, None]
        score = jnp.where(causal[None], score, -jnp.inf)
        _, sel = lax.top_k(score, top_k)
        valid = sel <= qpos[None, :, None]
        kg = jax.vmap(lambda kb, ib: kb[ib])(k, sel)
        vg = jax.vmap(lambda vb, ib: vb[ib])(v, sel)
        logits = jnp.einsum('bqhd,bqkhd->bqhk', qb, kg).astype(jnp.float32) * attn_scale
        logits = jnp.where(valid[:, :, None, :], logits, -jnp.inf)
        prob = jax.nn.softmax(logits, axis=-1).astype(v.dtype)
        return jnp.einsum('bqhk,bqkhd->bqhd', prob, vg)

    qpos_blocks = jnp.arange(L).reshape(nb, Q_BLOCK)
    out = lax.map(one_block, (to_blocks(q), to_blocks(qi), to_blocks(wi), qpos_blocks))
    return jnp.moveaxis(out, 0, 1).reshape(B, L, ATTN_WIDTH)


def causal_depthwise_conv(x, w, b):
    C = x.shape[-1]
    y = lax.conv_general_dilated(x, w.astype(x.dtype)[:, None, :], window_strides=(1,),
                                 padding=((CONV_WIDTH - 1, 0),),
                                 dimension_numbers=('NWC', 'WIO', 'NWC'),
                                 feature_group_count=C)
    return y + b.astype(x.dtype)


def rg_lru(x, w_a, b_a, w_x, b_x, lam):
    B, L, _ = x.shape
    xb = x.reshape(B, L, LRU_BLOCKS, LRU_BLOCK_DIM)
    r = jax.nn.sigmoid(jnp.einsum('bshi,hij->bshj', xb, w_a).reshape(B, L, LRU_WIDTH) + b_a)
    i = jax.nn.sigmoid(jnp.einsum('bshi,hij->bshj', xb, w_x).reshape(B, L, LRU_WIDTH) + b_x)
    log_a = -LRU_C * r.astype(jnp.float32) * jax.nn.softplus(-lam.astype(jnp.float32))
    a = jnp.exp(log_a)
    inp = jnp.sqrt(-jnp.expm1(2.0 * log_a)) * (i * x).astype(jnp.float32)

    def combine(left, right):
        a1, b1 = left
        a2, b2 = right
        return a1 * a2, a2 * b1 + b2

    _, h = lax.associative_scan(combine, (a, inp), axis=1)
    return h.astype(x.dtype)


def chunked_spatial_gating(u, v, w_s, b_s):
    B, L, _ = u.shape
    nc = L // CHUNK
    vg = v.reshape(B, nc, CHUNK, GMLP_GROUPS, GMLP_GROUP_DIM)
    mask = jnp.tril(jnp.ones((CHUNK, CHUNK), dtype=bool))
    w = jnp.where(mask[None], w_s, 0).astype(v.dtype)
    mixed = jnp.einsum('gts,bcsgd->bctgd', w, vg) + jnp.transpose(b_s).astype(v.dtype)[:, :, None]
    return u * mixed.reshape(B, L, GMLP_WIDTH)


def hybrid_layer(x, p_i, positions, g_pre_mix, w_in, conv_w, conv_b, w_rg_a, b_rg_a, w_rg_x, b_rg_x,
                 lru_lambda, g_gmlp_v, w_spatial, b_spatial, w_branch, w_out, g_post_mix,
                 g_pre_ffn, w_ffn_up, w_ffn_down, g_post_ffn, w_ple, w_ple_gate, g_post_ple):
    B, L, D = x.shape
    h = rms_norm(x, g_pre_mix)
    proj = h @ w_in
    offsets = [int(o) for o in np.cumsum(IN_SPLITS)[:-1]]
    q, k, v, qi, ki, wi, xr, gr, zu, zv, gate_logits = jnp.split(proj, offsets, axis=-1)

    q = apply_partial_rope(q.reshape(B, L, N_HEADS_ATTN, HEAD_DIM), positions, ROPE_DIM)
    k = apply_partial_rope(k.reshape(B, L, N_HEADS_ATTN, HEAD_DIM), positions, ROPE_DIM)
    v = v.reshape(B, L, N_HEADS_ATTN, HEAD_DIM)
    qi = apply_partial_rope(qi.reshape(B, L, IDX_HEADS, IDX_DIM), positions, IDX_ROPE_DIM)
    ki = apply_partial_rope(ki[:, :, None, :], positions, IDX_ROPE_DIM)[:, :, 0, :]
    y_a = dsa_attention(q, k, v, qi, ki, wi)

    xr = causal_depthwise_conv(xr, conv_w, conv_b)
    y_b = rg_lru(xr, w_rg_a, b_rg_a, w_rg_x, b_rg_x, lru_lambda) * jax.nn.gelu(gr)

    y_c = chunked_spatial_gating(jax.nn.gelu(zu), rms_norm(jax.nn.gelu(zv), g_gmlp_v), w_spatial, b_spatial)

    ys = jnp.stack([y_a, y_b, y_c], axis=0)
    branch = jnp.einsum('nbsw,nwd->nbsd', ys, w_branch)
    gates = jax.nn.sigmoid(gate_logits.reshape(B, L, N_BRANCH, D))
    merged = jnp.einsum('bsnd,nbsd->bsd', gates, branch)
    x = x + rms_norm(merged @ w_out, g_post_mix)

    h2 = rms_norm(x, g_pre_ffn)
    f = jnp.square(jax.nn.relu(h2 @ w_ffn_up)) @ w_ffn_down
    x = x + rms_norm(f, g_post_ffn)

    ple = (p_i.astype(x.dtype) @ w_ple) * jax.nn.sigmoid(x @ w_ple_gate)
    return x + rms_norm(ple, g_post_ple)


def setup_inputs(seed: int = 0) -> dict:
    key = jax.random.key(seed)
    ks = jax.random.split(key, 32)
    f32 = jnp.float32

    def nrm(k, shape, fan_in):
        return jax.random.normal(k, shape, f32) * (fan_in ** -0.5)

    def gain(k, n):
        return 1.0 + 0.05 * jax.random.normal(k, (DEPTH, n), f32)

    u = jax.random.uniform(ks[10], (DEPTH, LRU_WIDTH), f32, 0.9, 0.999)
    base = u ** (1.0 / LRU_C)
    lru_lambda = jnp.log(base) - jnp.log1p(-base)
    return {
        'x': jax.random.normal(ks[0], (BATCH, SEQ, D_MODEL), f32),
        'p': jax.random.normal(ks[1], (DEPTH, BATCH, SEQ, PLE_DIM), f32),
        'positions': jnp.broadcast_to(jnp.arange(SEQ, dtype=jnp.int32), (BATCH, SEQ)),
        'g_pre_mix': gain(ks[2], D_MODEL),
        'w_in': nrm(ks[3], (DEPTH, D_MODEL, IN_WIDTH), D_MODEL),
        'conv_w': nrm(ks[4], (DEPTH, CONV_WIDTH, LRU_WIDTH), CONV_WIDTH),
        'conv_b': 0.01 * jax.random.normal(ks[5], (DEPTH, LRU_WIDTH), f32),
        'w_rg_a': nrm(ks[6], (DEPTH, LRU_BLOCKS, LRU_BLOCK_DIM, LRU_BLOCK_DIM), LRU_BLOCK_DIM),
        'b_rg_a': 0.01 * jax.random.normal(ks[7], (DEPTH, LRU_WIDTH), f32),
        'w_rg_x': nrm(ks[8], (DEPTH, LRU_BLOCKS, LRU_BLOCK_DIM, LRU_BLOCK_DIM), LRU_BLOCK_DIM),
        'b_rg_x': 0.01 * jax.random.normal(ks[9], (DEPTH, LRU_WIDTH), f32),
        'lru_lambda': lru_lambda,
        'g_gmlp_v': gain(ks[11], GMLP_WIDTH),
        'w_spatial': nrm(ks[12], (DEPTH, GMLP_GROUPS, CHUNK, CHUNK), CHUNK),
        'b_spatial': 1.0 + 0.1 * jax.random.normal(ks[13], (DEPTH, GMLP_GROUPS, CHUNK), f32),
        'w_branch': nrm(ks[14], (DEPTH, N_BRANCH, BRANCH_WIDTH, D_MODEL), BRANCH_WIDTH),
        'w_out': nrm(ks[15], (DEPTH, D_MODEL, D_MODEL), D_MODEL),
        'g_post_mix': gain(ks[16], D_MODEL),
        'g_pre_ffn': gain(ks[17], D_MODEL),
        'w_ffn_up': nrm(ks[18], (DEPTH, D_MODEL, FFN_DIM), D_MODEL),
        'w_ffn_down': nrm(ks[19], (DEPTH, FFN_DIM, D_MODEL), FFN_DIM),
        'g_post_ffn': gain(ks[20], D_MODEL),
        'w_ple': nrm(ks[21], (DEPTH, PLE_DIM, D_MODEL), PLE_DIM),
        'w_ple_gate': nrm(ks[22], (DEPTH, D_MODEL, D_MODEL), D_MODEL),
        'g_post_ple': gain(ks[23], D_MODEL),
    }


def reference(x, p, positions, g_pre_mix, w_in, conv_w, conv_b, w_rg_a, b_rg_a, w_rg_x, b_rg_x,
              lru_lambda, g_gmlp_v, w_spatial, b_spatial, w_branch, w_out, g_post_mix,
              g_pre_ffn, w_ffn_up, w_ffn_down, g_post_ffn, w_ple, w_ple_gate, g_post_ple):
    for i in range(DEPTH):
        x = hybrid_layer(x, p[i], positions, g_pre_mix[i], w_in[i], conv_w[i], conv_b[i],
                         w_rg_a[i], b_rg_a[i], w_rg_x[i], b_rg_x[i], lru_lambda[i], g_gmlp_v[i],
                         w_spatial[i], b_spatial[i], w_branch[i], w_out[i], g_post_mix[i],
                         g_pre_ffn[i], w_ffn_up[i], w_ffn_down[i], g_post_ffn[i],
                         w_ple[i], w_ple_gate[i], g_post_ple[i])
    return x
```

```cpp
#include <hip/hip_runtime.h>
#include <cstdio>
#include <cstdint>
namespace pg8 {
#define PG8_LAS __attribute__((address_space(3)))
typedef unsigned short bf16_t;
typedef short bf16x8 __attribute__((ext_vector_type(8)));
typedef float f32x4 __attribute__((ext_vector_type(4)));
typedef unsigned u32x4 __attribute__((ext_vector_type(4)));
constexpr int BM = 256, BK = 64, HALF = 128, HTB = HALF * BK * 2  , STAGE_BYTES = 8 * HTB, NXCD = 8, WGM = 8;

__host__ __device__ __forceinline__ int lds_byte(int r, int c) { const int st = (r >> 4) * 2 + (c >> 5), rr = r & 15, cc = c & 31, ob = rr * 64 + cc * 2; return st * 1024 + (ob ^ (((ob >> 9) & 1) << 5)); }
__host__ __device__ __forceinline__ void stage_rc(int b, int& R, int& C) { const int st = b / 1024, sb = b % 1024, swz = sb ^ (((sb >> 9) & 1) << 5); R = (st >> 1) * 16 + swz / 64; C = (st & 1) * 32 + (swz % 64) / 2; }
__host__ __device__ __forceinline__ int perm32(int rho) { const int n = rho >> 4, i = rho & 15; return 8 * (i >> 2) + 4 * n + (i & 3); }

struct Unit { int pm, pn; };
struct Gemm { const bf16_t* A; const bf16_t* Bt; int M, N, K; };

struct StaticOrder {
    int nM, nN, nwg, G, c;
    __host__ __device__ void init(int M, int N, int G_, int c_) { nM = M / BM; nN = N / BM; nwg = nM * nN; G = G_; c = c_; }
    __host__ __device__ bool next(int i, Unit& u) const {
        const long L = (long)i * G + c; if (L >= nwg) return false;
        int wgid = (int)L; { const int q = nwg / NXCD, r = nwg % NXCD, xcd = wgid % NXCD, off = wgid / NXCD; wgid = (xcd < r ? xcd * (q + 1) : r * (q + 1) + (xcd - r) * q) + off; }
        const int nig = WGM * nN, gid = wgid / nig, fm = gid * WGM, gsz = (nM - fm) < WGM ? (nM - fm) : WGM;
        u.pm = fm + ((wgid % nig) % gsz); u.pn = (wgid % nig) / gsz; return true;
    }
    __device__ __forceinline__ void a_ready(const Unit&) const {}
    __device__ __forceinline__ void done(const Unit&) const {}
};


typedef float f32x2_t __attribute__((ext_vector_type(2))); typedef __bf16 bf16x2_t __attribute__((ext_vector_type(2)));
__device__ __forceinline__ unsigned cvt_pk_bf16(float lo, float hi) { f32x2_t v = {lo, hi}; bf16x2_t b = __builtin_convertvector(v, bf16x2_t); return __builtin_bit_cast(unsigned, b); }
__device__ __forceinline__ float bflo(unsigned w) { return __builtin_bit_cast(float, w << 16); }
__device__ __forceinline__ float bfhi(unsigned w) { return __builtin_bit_cast(float, w & 0xffff0000u); }
__device__ __forceinline__ float sigm(float x) { return __builtin_amdgcn_rcpf(1.f + __expf(-x)); }
__device__ __forceinline__ float gelu_tanh(float x) { const float u = 0.7978845608028654f * (x + 0.044715f * x * x * x); return x * __builtin_amdgcn_rcpf(1.f + __expf(-2.f * u)); }
__device__ __forceinline__ void unpack8(const u32x4 a, float (&v)[8]) { v[0] = bflo(a.x); v[1] = bfhi(a.x); v[2] = bflo(a.y); v[3] = bfhi(a.y); v[4] = bflo(a.z); v[5] = bfhi(a.z); v[6] = bflo(a.w); v[7] = bfhi(a.w); }
__device__ __forceinline__ u32x4 pack8(const float (&v)[8]) { u32x4 w; w.x = cvt_pk_bf16(v[0], v[1]); w.y = cvt_pk_bf16(v[2], v[3]); w.z = cvt_pk_bf16(v[4], v[5]); w.w = cvt_pk_bf16(v[6], v[7]); return w; }

template <int MODE  > struct EpiGen {
    static constexpr bool PERM = true, AFTER_DRAIN = false;
    bf16_t* O; int ldc; const bf16_t* aux;
    __device__ __forceinline__ void operator()(const f32x4 (&acc)[2][2][4][2], const Unit& u, int wr, int wc, int fr, int fq) const {
        const int row0 = u.pm * BM + wr * 64 + fr, col0 = u.pn * BM + wc * 32 + 8 * fq;
#pragma unroll
        for (int ai = 0; ai < 2; ++ai)
#pragma unroll
            for (int m = 0; m < 4; ++m) { const size_t ro = (size_t)(row0 + ai * HALF + m * 16) * ldc + col0;
#pragma unroll
                for (int bj = 0; bj < 2; ++bj) { const f32x4 v0 = acc[ai][bj][m][0], v1 = acc[ai][bj][m][1];
                    float v[8] = {v0[0], v0[1], v0[2], v0[3], v1[0], v1[1], v1[2], v1[3]};
                    if (MODE == 1) {
#pragma unroll
                        for (int k = 0; k < 8; ++k) { const float r = fmaxf(v[k], 0.f); v[k] = r * r; } }
                    if (MODE == 2) {
#pragma unroll
                        for (int k = 0; k < 8; ++k) v[k] = sigm(v[k]); }
                    if (MODE == 3) { float a[8]; unpack8(*(const u32x4*)(aux + ro + bj * HALF), a);
#pragma unroll
                        for (int k = 0; k < 8; ++k) v[k] *= a[k]; }
                    *(u32x4*)(O + ro + bj * HALF) = pack8(v); if (MODE == 3) __builtin_amdgcn_sched_barrier(0); } }
    }
};

struct EpiInA {
    static constexpr bool PERM = true, AFTER_DRAIN = false;
    bf16_t *Q, *Kb, *V, *QI, *XR, *GR, *ZU, *ZV, *KI; float* WI; const float* rope;
    __device__ __forceinline__ void operator()(const f32x4 (&acc)[2][2][4][2], const Unit& u, int wr, int wc, int fr, int fq) const {
        const int pn = u.pn, seg = pn >> 1;
        const int row0 = u.pm * BM + wr * 64 + fr, ct0 = wc * 32 + 8 * fq;
        const bool ropelane = ((wc & 1) == 0) && (fq < 2);
        if (pn < 16) {
            bf16_t* dst = seg == 0 ? Q : seg == 1 ? Kb : seg == 2 ? V : seg == 3 ? QI : seg == 4 ? XR : seg == 5 ? GR : seg == 6 ? ZU : ZV;
            const bool dorope = (seg == 0 || seg == 1 || seg == 3) && ropelane;
            const bool dogelu = seg >= 5;
            const float sc = (seg == 0) ? 0.125f : 1.f;
#pragma unroll
            for (int ai = 0; ai < 2; ++ai)
#pragma unroll
                for (int m = 0; m < 4; ++m) { const int row = row0 + ai * HALF + m * 16;
                    f32x4 cs0 = (f32x4){1.f, 0.f, 1.f, 0.f}, cs1 = cs0;
                    if (dorope) { cs0 = *(const f32x4*)(rope + (size_t)row * 16 + fq * 8); cs1 = *(const f32x4*)(rope + (size_t)row * 16 + fq * 8 + 4); }
#pragma unroll
                    for (int bj = 0; bj < 2; ++bj) { const f32x4 v0 = acc[ai][bj][m][0], v1 = acc[ai][bj][m][1];
                        float v[8] = {v0[0], v0[1], v0[2], v0[3], v1[0], v1[1], v1[2], v1[3]};
                        if (dorope) { const float c[4] = {cs0[0], cs0[2], cs1[0], cs1[2]}, s[4] = {cs0[1], cs0[3], cs1[1], cs1[3]};
#pragma unroll
                            for (int i = 0; i < 4; ++i) { const float x1 = v[2 * i], x2 = v[2 * i + 1]; v[2 * i] = x1 * c[i] - x2 * s[i]; v[2 * i + 1] = x2 * c[i] + x1 * s[i]; } }
                        if (dogelu) {
#pragma unroll
                            for (int k = 0; k < 8; ++k) v[k] = gelu_tanh(v[k]); }
#pragma unroll
                        for (int k = 0; k < 8; ++k) v[k] *= sc;
                        *(u32x4*)(dst + (size_t)row * 512 + (pn & 1) * 256 + bj * HALF + ct0) = pack8(v); } }
        } else {
#pragma unroll
            for (int ai = 0; ai < 2; ++ai)
#pragma unroll
                for (int m = 0; m < 4; ++m) { const int row = row0 + ai * HALF + m * 16;
                    const f32x4 v0 = acc[ai][0][m][0], v1 = acc[ai][0][m][1];
                    float v[8] = {v0[0], v0[1], v0[2], v0[3], v1[0], v1[1], v1[2], v1[3]};
                    if (wc < 2) {
                        if (wc == 0 && fq < 2) { const f32x4 cs0 = *(const f32x4*)(rope + (size_t)row * 16 + fq * 8), cs1 = *(const f32x4*)(rope + (size_t)row * 16 + fq * 8 + 4);
                            const float c[4] = {cs0[0], cs0[2], cs1[0], cs1[2]}, s[4] = {cs0[1], cs0[3], cs1[1], cs1[3]};
#pragma unroll
                            for (int i = 0; i < 4; ++i) { const float x1 = v[2 * i], x2 = v[2 * i + 1]; v[2 * i] = x1 * c[i] - x2 * s[i]; v[2 * i + 1] = x2 * c[i] + x1 * s[i]; } }
                        *(u32x4*)(KI + (size_t)row * 64 + ct0) = pack8(v);
                    } else if (wc == 2 && fq == 0) {
                        const float is = 0.04419417382415922f;
                        *(f32x4*)(WI + (size_t)row * 8) = (f32x4){v[0] * is, v[1] * is, v[2] * is, v[3] * is};
                        *(f32x4*)(WI + (size_t)row * 8 + 4) = (f32x4){v[4] * is, v[5] * is, v[6] * is, v[7] * is};
                    } }
        }
    }
};

struct EpiMerge {
    static constexpr bool PERM = true, AFTER_DRAIN = false;
    bf16_t* Mg; const bf16_t* G;
    __device__ __forceinline__ void operator()(const f32x4 (&acc)[2][2][4][2], const Unit& u, int wr, int wc, int fr, int fq) const {
        const int n = u.pm >> 7, pm = u.pm & 127, pn = u.pn & 3;
        const int row0 = pm * BM + wr * 64 + fr, col0 = pn * BM + wc * 32 + 8 * fq;
#pragma unroll
        for (int ai = 0; ai < 2; ++ai)
#pragma unroll
            for (int m = 0; m < 4; ++m) { const int row = row0 + ai * HALF + m * 16;
#pragma unroll
                for (int bj = 0; bj < 2; ++bj) { const int col = col0 + bj * HALF; const f32x4 v0 = acc[ai][bj][m][0], v1 = acc[ai][bj][m][1];
                    float v[8] = {v0[0], v0[1], v0[2], v0[3], v1[0], v1[1], v1[2], v1[3]}, g[8];
                    unpack8(*(const u32x4*)(G + (size_t)row * 3072 + n * 1024 + col), g);
#pragma unroll
                    for (int k = 0; k < 8; ++k) v[k] *= g[k];
                    bf16_t* op = Mg + (size_t)row * 1024 + col;
                    if (n > 0) { float o[8]; unpack8(*(const u32x4*)op, o);
#pragma unroll
                        for (int k = 0; k < 8; ++k) v[k] += o[k]; }
                    *(u32x4*)op = pack8(v); __builtin_amdgcn_sched_barrier(0); } }
    }
};
struct MergeOrder {
    StaticOrder so;
    __device__ bool next(int i, Unit& u) const { const int n = i % 3; Unit t; if (!so.next(i / 3, t)) return false; u.pm = n * 128 + t.pm; u.pn = n * 4 + t.pn; return true; }
    __device__ __forceinline__ void a_ready(const Unit&) const {}
    __device__ __forceinline__ void done(const Unit&) const {}
};

template <class Epi, class Sched, bool ALIGN_EPI = false, bool SP2 = false>
__device__ __forceinline__ void gemm_phase(PG8_LAS unsigned char* lds, const Gemm g, const Sched& S, const Epi& E, const int wave_id) {
    int tid_; asm volatile("v_mbcnt_lo_u32_b32 %0, -1, 0\n\tv_mbcnt_hi_u32_b32 %0, -1, %0" : "=v"(tid_)); tid_ += wave_id * 64; asm volatile("" : "+v"(tid_));
    const int tid = tid_, wid = __builtin_amdgcn_readfirstlane(tid >> 6), lane = tid & 63, wr = wid >> 2, wc = wid & 3, fr = lane & 15, fq = lane >> 4;
    const int K = g.K, nt = K / BK;
    unsigned voffA[2], voffB[2];
#pragma unroll
    for (int i = 0; i < 2; ++i) { int R, C; stage_rc(tid * 16 + i * 8192, R, C); const int Rb = Epi::PERM ? ((R & ~31) + perm32(R & 31)) : R;
        voffA[i] = (unsigned)(R * K + C) * 2u; voffB[i] = (unsigned)(Rb * K + C) * 2u; }
    const size_t kstep = (size_t)(BK * 2);
    const size_t hstep = (size_t)HALF * K * 2;
    const size_t tstep = 2 * hstep;
    const unsigned ldsw = (unsigned)wid * 1024u;
    const int aoff = lds_byte(wr * 64 + fr, fq * 8), boff = lds_byte(wc * 32 + fr, fq * 8);
#define PG8_SA(b, h) (((b) * 2 + (h)) * HTB)
#define PG8_SB(b, h) ((4 + (b) * 2 + (h)) * HTB)
#define PG8_STAGE(bufoff, gbase, voff) do { _Pragma("unroll") for (int _i = 0; _i < 2; ++_i) \
        __builtin_amdgcn_global_load_lds((const unsigned*)((const char*)(gbase) + (voff)[_i]), (PG8_LAS unsigned*)(lds + (bufoff) + ldsw + _i * 8192), 16, 0, 0); } while (0)
#define PG8_LDA(dst, b, h) do { _Pragma("unroll") for (int m = 0; m < 4; ++m) _Pragma("unroll") for (int k = 0; k < 2; ++k) dst[m][k] = *(const PG8_LAS bf16x8*)(lds + PG8_SA(b, h) + aoff + m * 2048 + k * 1024); } while (0)
#define PG8_LDB(dst, b, h) do { _Pragma("unroll") for (int n = 0; n < 2; ++n) _Pragma("unroll") for (int k = 0; k < 2; ++k) dst[n][k] = *(const PG8_LAS bf16x8*)(lds + PG8_SB(b, h) + boff + n * 2048 + k * 1024); } while (0)
#define PG8_MMA(ai, bj, At, Bt) do { __builtin_amdgcn_s_setprio(1); _Pragma("unroll") for (int m = 0; m < 4; ++m) _Pragma("unroll") for (int n = 0; n < 2; ++n) _Pragma("unroll") for (int k = 0; k < 2; ++k) \
        acc[ai][bj][m][n] = __builtin_amdgcn_mfma_f32_16x16x32_bf16(Bt[n][k], At[m][k], acc[ai][bj][m][n], 0, 0, 0); __builtin_amdgcn_s_setprio(0); } while (0)
#define PG8_WAIT_V(n) asm volatile("s_waitcnt vmcnt(" #n ")" ::: "memory")
#define PG8_WAIT_L(n) asm volatile("s_waitcnt lgkmcnt(" #n ")" ::: "memory")
#define PG8_BAR __builtin_amdgcn_s_barrier()
#define PG8_SCHED __builtin_amdgcn_sched_barrier(0)
    Unit cur, nxt; int ui = 0;
    if (!S.next(0, cur)) return;
    f32x4 acc[2][2][4][2];
#pragma unroll
    for (int a = 0; a < 2; ++a)
#pragma unroll
        for (int b = 0; b < 2; ++b)
#pragma unroll
            for (int m = 0; m < 4; ++m)
#pragma unroll
                for (int n = 0; n < 2; ++n) acc[a][b][m][n] = (f32x4){0.f, 0.f, 0.f, 0.f};
    bf16x8 At[4][2], B0[2][2], B1[2][2];
    const char* cA = (const char*)g.A + (size_t)cur.pm * tstep; const char* cB = (const char*)g.Bt + (size_t)cur.pn * tstep;
    S.a_ready(cur);
    if constexpr (SP2) {
        PG8_STAGE(PG8_SB(0, 0), cB, voffB); PG8_STAGE(PG8_SB(0, 1), cB + hstep, voffB); PG8_STAGE(PG8_SA(0, 0), cA, voffA); PG8_STAGE(PG8_SA(0, 1), cA + hstep, voffA);
        if (wr == 1) PG8_BAR;
        PG8_WAIT_V(2); PG8_BAR;
        PG8_STAGE(PG8_SB(1, 0), cB + kstep, voffB); PG8_STAGE(PG8_SA(1, 0), cA + kstep, voffA); PG8_STAGE(PG8_SB(1, 1), cB + hstep + kstep, voffB);
        PG8_WAIT_V(6); PG8_BAR;
    } else {
        PG8_STAGE(PG8_SB(0, 0), cB, voffB); PG8_STAGE(PG8_SA(0, 0), cA, voffA); PG8_STAGE(PG8_SB(0, 1), cB + hstep, voffB); PG8_STAGE(PG8_SA(0, 1), cA + hstep, voffA);
        if (wr == 1) PG8_BAR;
        PG8_WAIT_V(4); PG8_BAR;
        PG8_STAGE(PG8_SB(1, 0), cB + kstep, voffB); PG8_STAGE(PG8_SA(1, 0), cA + kstep, voffA); PG8_STAGE(PG8_SB(1, 1), cB + hstep + kstep, voffB);
        PG8_WAIT_V(6); PG8_BAR;
    }
    for (;;) {
        const bool has_next = S.next(ui + 1, nxt);
        const char* nA = has_next ? (const char*)g.A + (size_t)nxt.pm * tstep : cA; const char* nB = has_next ? (const char*)g.Bt + (size_t)nxt.pn * tstep : cB;
        for (int t = 0; t < nt; t += 2) {
            const bool last = (t == nt - 2);
            const char* a1 = cA + (size_t)(t + 1) * kstep;
            const char* a2 = last ? nA : cA + (size_t)(t + 2) * kstep; const char* b2 = last ? nB : cB + (size_t)(t + 2) * kstep;
            const char* a3 = a2 + kstep; const char* b3 = b2 + kstep;
            if (last && has_next) S.a_ready(nxt);
            if constexpr (SP2) {
            PG8_LDB(B0, 0, 0); PG8_LDB(B1, 0, 1); PG8_SCHED; PG8_LDA(At, 0, 0); PG8_STAGE(PG8_SA(1, 1), a1 + hstep, voffA);
            PG8_WAIT_V(8); PG8_WAIT_L(0); PG8_BAR; PG8_MMA(0, 0, At, B0); PG8_MMA(0, 1, At, B1); PG8_BAR; PG8_SCHED;
            PG8_LDA(At, 0, 1); PG8_STAGE(PG8_SB(0, 0), b2, voffB); PG8_STAGE(PG8_SB(0, 1), b2 + hstep, voffB); PG8_STAGE(PG8_SA(0, 0), a2, voffA);
            PG8_WAIT_V(8); PG8_WAIT_L(0); PG8_BAR; PG8_MMA(1, 0, At, B0); PG8_MMA(1, 1, At, B1); PG8_BAR; PG8_SCHED;
            PG8_LDB(B0, 1, 0); PG8_LDB(B1, 1, 1); PG8_SCHED; PG8_LDA(At, 1, 0); PG8_STAGE(PG8_SA(0, 1), a2 + hstep, voffA);
            PG8_WAIT_V(8); PG8_WAIT_L(0); PG8_BAR; PG8_MMA(0, 0, At, B0); PG8_MMA(0, 1, At, B1); PG8_BAR; PG8_SCHED;
            PG8_LDA(At, 1, 1); PG8_STAGE(PG8_SB(1, 0), b3, voffB); PG8_STAGE(PG8_SB(1, 1), b3 + hstep, voffB); PG8_STAGE(PG8_SA(1, 0), a3, voffA);
            PG8_WAIT_V(8); PG8_WAIT_L(0); PG8_BAR; PG8_MMA(1, 0, At, B0); PG8_MMA(1, 1, At, B1); PG8_BAR; PG8_SCHED;
            } else {
            PG8_LDB(B0, 0, 0); PG8_SCHED; PG8_LDA(At, 0, 0); PG8_STAGE(PG8_SA(1, 1), a1 + hstep, voffA);
            PG8_WAIT_L(8); PG8_BAR; PG8_WAIT_L(0); PG8_MMA(0, 0, At, B0); PG8_BAR; PG8_SCHED;
            PG8_LDB(B1, 0, 1); PG8_STAGE(PG8_SB(0, 0), b2, voffB);
            PG8_BAR; PG8_WAIT_L(0); PG8_MMA(0, 1, At, B1); PG8_BAR;
            PG8_LDA(At, 0, 1); PG8_STAGE(PG8_SA(0, 0), a2, voffA);
            PG8_BAR; PG8_WAIT_L(0); PG8_MMA(1, 0, At, B0); PG8_BAR; PG8_SCHED;
            PG8_STAGE(PG8_SB(0, 1), b2 + hstep, voffB);
            PG8_WAIT_V(6); PG8_BAR; PG8_MMA(1, 1, At, B1); PG8_BAR;
            PG8_LDB(B0, 1, 0); PG8_SCHED; PG8_LDA(At, 1, 0); PG8_STAGE(PG8_SA(0, 1), a2 + hstep, voffA);
            PG8_WAIT_L(8); PG8_BAR; PG8_WAIT_L(0); PG8_MMA(0, 0, At, B0); PG8_BAR; PG8_SCHED;
            PG8_LDB(B1, 1, 1); PG8_STAGE(PG8_SB(1, 0), b3, voffB);
            PG8_BAR; PG8_WAIT_L(0); PG8_MMA(0, 1, At, B1); PG8_BAR;
            PG8_LDA(At, 1, 1); PG8_STAGE(PG8_SA(1, 0), a3, voffA);
            PG8_BAR; PG8_WAIT_L(0); PG8_MMA(1, 0, At, B0); PG8_BAR; PG8_SCHED;
            PG8_STAGE(PG8_SB(1, 1), b3 + hstep, voffB);
            PG8_WAIT_V(6); PG8_BAR; PG8_MMA(1, 1, At, B1); PG8_BAR;
            }
        }
        if constexpr (ALIGN_EPI) { if (wr == 0) PG8_BAR; }
        if constexpr (!Epi::AFTER_DRAIN) { int l_; asm volatile("v_mbcnt_lo_u32_b32 %0, -1, 0\n\tv_mbcnt_hi_u32_b32 %0, -1, %0" : "=v"(l_)); E(acc, cur, wr, wc, l_ & 15, l_ >> 4); S.done(cur); }
        if (!has_next) break;
#pragma unroll
        for (int a = 0; a < 2; ++a)
#pragma unroll
            for (int b = 0; b < 2; ++b)
#pragma unroll
                for (int m = 0; m < 4; ++m)
#pragma unroll
                    for (int n = 0; n < 2; ++n) acc[a][b][m][n] = (f32x4){0.f, 0.f, 0.f, 0.f};
        cur = nxt; cA = nA; cB = nB; ++ui;
        if constexpr (ALIGN_EPI) { if (wr == 1) PG8_BAR; }
    }
    PG8_WAIT_V(0);
    if constexpr (!ALIGN_EPI) { if (wr == 0) PG8_BAR; }
    PG8_BAR;
    if constexpr (Epi::AFTER_DRAIN) { E.fused(acc, cur, wr, wc, fr, fq, lds, wid, lane); S.done(cur); }
#undef PG8_SA
#undef PG8_SB
#undef PG8_STAGE
#undef PG8_LDA
#undef PG8_LDB
#undef PG8_MMA
#undef PG8_WAIT_V
#undef PG8_WAIT_L
#undef PG8_BAR
#undef PG8_SCHED
}
}

constexpr int NWAVES = 8;
#ifndef MK_ONE_LAUNCH
#define MK_ONE_LAUNCH 0
#endif
constexpr int NB = 8, SEQ = 4096, D = 1024, M = NB * SEQ, NLAYER = 2;
constexpr int INW = 7240, NA = 17 * 256, NG = 3072, NIN = NA + NG, FF = 4096, PLE = 256;
constexpr float EPS = 1e-6f;
constexpr int PH_PER_LAYER = 13, NPH = 1 + NLAYER * PH_PER_LAYER;
constexpr size_t MiB = 1u << 20;
constexpr size_t WS_CTL = 0, CTL_ZERO_BYTES = 1 * MiB;
constexpr size_t WS_ROPE = 1 * MiB;
constexpr size_t WS_AGG = 3 * MiB;
constexpr size_t WS_W = 4 * MiB, W_LAYER = 38 * MiB;
constexpr size_t WO_IN = 0, WO_BR = WO_IN + (size_t)NIN * D * 2, WO_OUT = WO_BR + 3 * MiB, WO_UP = WO_OUT + 2 * MiB, WO_DN = WO_UP + 8 * MiB, WO_PLE = WO_DN + 8 * MiB, WO_PG = WO_PLE + MiB / 2;
static_assert(WO_PG + 2 * MiB == W_LAYER, "weight map");
constexpr size_t WS_P = 80 * MiB;
constexpr size_t WS_H = 112 * MiB;
constexpr size_t WS_Q = 176 * MiB, WS_K = 208 * MiB, WS_V = 240 * MiB, WS_XR = 272 * MiB, WS_GR = 304 * MiB, WS_ZV = 336 * MiB;
constexpr size_t WS_G = 176 * MiB;
constexpr size_t WS_QI = 368 * MiB, WS_ZU = 400 * MiB, WS_YC = 432 * MiB;
constexpr size_t WS_KI = 464 * MiB, WS_WI = 468 * MiB, WS_SEL = 469 * MiB;
constexpr size_t WS_T = 176 * MiB;
constexpr size_t WS_U = 176 * MiB;
constexpr size_t WS_T2 = 432 * MiB;
constexpr size_t WS_S = 176 * MiB, WS_T3 = 240 * MiB;
constexpr size_t WS_END = 496 * MiB;
constexpr int CW_BAR = 4096;
constexpr int LDS_BYTES = 155648;
constexpr int MISC_OFF = 147456 + 320;

#define GAS __attribute__((address_space(1)))
#define LAS __attribute__((address_space(3)))
typedef unsigned short bf16;
typedef unsigned v4u __attribute__((ext_vector_type(4)));
typedef float f32x4 __attribute__((ext_vector_type(4)));
typedef float f32x2 __attribute__((ext_vector_type(2)));
typedef GAS unsigned gu32;
#define RLX_AGENT __ATOMIC_RELAXED, __HIP_MEMORY_SCOPE_AGENT
#define LDS_WAIT() asm volatile("s_waitcnt lgkmcnt(0)" ::: "memory")
#define VM_WAIT() asm volatile("s_waitcnt vmcnt(0)" ::: "memory")
using pg8::bflo; using pg8::bfhi; using pg8::unpack8; using pg8::pack8; using pg8::sigm;
__device__ __forceinline__ float bf2f(bf16 b) { return __builtin_bit_cast(float, (unsigned)b << 16); }
__device__ __forceinline__ unsigned f2bf(float f) { unsigned u = __builtin_bit_cast(unsigned, f); return (u + 0x7fffu + ((u >> 16) & 1u)) >> 16; }
__device__ __forceinline__ unsigned pk2(float lo, float hi) { return f2bf(lo) | (f2bf(hi) << 16); }

__device__ __forceinline__ int lane_id() { int l; asm volatile("v_mbcnt_lo_u32_b32 %0, -1, 0\n\tv_mbcnt_hi_u32_b32 %0, -1, %0" : "=v"(l)); return l; }
#define XB_TMO      128
#define XB_XCNT(j)  (256  + 64 * (j))
#define XB_XSUB(j)  (1280 + 64 * (j))
#define XB_XGEN(j)  (2304 + 64 * (j))
#define XB_TOP      3328
#define XB_TOPGEN   3392
#define XCD_BAR_WORDS 3456
#define XB_SPIN_CAP (1u << 18)

__device__ __forceinline__ unsigned xb_ld(unsigned* p)              { return __hip_atomic_load(p, __ATOMIC_RELAXED, __HIP_MEMORY_SCOPE_AGENT); }
__device__ __forceinline__ unsigned xb_add(unsigned* p, unsigned v) { return __hip_atomic_fetch_add(p, v, __ATOMIC_RELAXED, __HIP_MEMORY_SCOPE_AGENT); }
__device__ __forceinline__ unsigned xb_xcc_id() { return (unsigned)__builtin_amdgcn_s_getreg((3 << 11) | 20) & 0xFu; }
#define XB_SPIN(cond, bar) do { unsigned _sp = 0; while (cond) { __builtin_amdgcn_s_sleep(1); \
    if ((++_sp & 255u) == 0u) { if (xb_ld(&(bar)[XB_TMO])) break; if (_sp > XB_SPIN_CAP) { atomicAdd(&(bar)[XB_TMO], 1u); break; } } } } while (0)

struct XcdBarrier {
    unsigned* bar; unsigned x;
    volatile LAS unsigned* st;
    int w0;
};

__device__ __forceinline__ XcdBarrier xcd_barrier_post(unsigned* bar, volatile LAS unsigned* st, int w0) {
    XcdBarrier b; b.bar = bar; b.x = xb_xcc_id(); b.st = st; b.w0 = w0;
    if (w0 == 0 && lane_id() == 0) (void)xb_add(&bar[XB_XCNT(b.x)], 1u);
    return b;
}
__device__ __forceinline__ void xcd_barrier_complete(unsigned* bar, unsigned x, unsigned& nloc, unsigned& nx) {
    const unsigned G = gridDim.x * gridDim.y * gridDim.z;
    unsigned sum, cnt, mine, sp = 0u;
    for (;;) {
        sum = 0u; cnt = 0u; mine = 0u;
#pragma unroll
        for (unsigned j = 0; j < 16; ++j) { const unsigned c = xb_ld(&bar[XB_XCNT(j)]); sum += c; cnt += (c > 0u) ? 1u : 0u; mine = (j == x) ? c : mine; }
        if (sum == G) break;
        __builtin_amdgcn_s_sleep(1);
        if ((++sp & 255u) == 0u) { if (xb_ld(&bar[XB_TMO])) break; if (sp > XB_SPIN_CAP) { atomicAdd(&bar[XB_TMO], 1u); break; } }
    }
    nloc = mine > 0u ? mine : 1u; nx = cnt > 0u ? cnt : 1u;
}

__device__ __forceinline__ void xcd_barrier(const XcdBarrier& b) {
    asm volatile("s_waitcnt vmcnt(0)" ::: "memory");
    __syncthreads();
    if (b.w0 == 0 && lane_id() == 0) {
        unsigned* bar = b.bar;
        __builtin_amdgcn_s_waitcnt(0);
        unsigned nloc = b.st[0], nx = b.st[1];
        if (nloc == 0u) { xcd_barrier_complete(bar, b.x, nloc, nx); b.st[0] = nloc; b.st[1] = nx; }
        const unsigned old = xb_add(&bar[XB_XSUB(b.x)], 1u);
        const unsigned gen = old / nloc;
        if (old + 1u == (gen + 1u) * nloc) {
            __builtin_amdgcn_fence(__ATOMIC_RELEASE, "agent");
            asm volatile("s_waitcnt vmcnt(0)" ::: "memory");
            const unsigned og = xb_add(&bar[XB_TOP], 1u);
            const unsigned tg = og / nx;
            if (og + 1u == (tg + 1u) * nx) xb_add(&bar[XB_TOPGEN], 1u);
            else XB_SPIN(xb_ld(&bar[XB_TOPGEN]) == tg, bar);
            __builtin_amdgcn_fence(__ATOMIC_ACQUIRE, "agent");
            xb_add(&bar[XB_XGEN(b.x)], 1u);
            asm volatile("s_waitcnt vmcnt(0)" ::: "memory");
        } else {
            XB_SPIN(xb_ld(&bar[XB_XGEN(b.x)]) == gen, bar);
            __builtin_amdgcn_fence(__ATOMIC_ACQUIRE, "agent");
            asm volatile("s_waitcnt vmcnt(0)" ::: "memory");
        }
    }
    __syncthreads();
}


__device__ __forceinline__ float wave_sum(float v) {
#pragma unroll
    for (int o = 1; o < 64; o <<= 1) v += __shfl_xor(v, o);
    return v;
}
__device__ __forceinline__ float wave_max(float v) {
#pragma unroll
    for (int o = 1; o < 64; o <<= 1) v = fmaxf(v, __shfl_xor(v, o));
    return v;
}
__device__ __forceinline__ int prefix_popc(unsigned long long m) { return (int)__builtin_amdgcn_mbcnt_hi((unsigned)(m >> 32), __builtin_amdgcn_mbcnt_lo((unsigned)m, 0u)); }

__device__ __forceinline__ void zero_rows(bf16* Y, int blk, int G, int tid) { for (size_t e = (size_t)(blk * 512 + tid) * 8; e < (size_t)M * 512; e += (size_t)G * 512 * 8) *(GAS v4u*)(Y + e) = (v4u){0u, 0u, 0u, 0u}; }
template <class Map>
__device__ __forceinline__ void transpose_item(const float* W, int K, int Nsrc, bf16* WT, int nblk, LAS float* scr, int item, int lane, Map map) {
    const int kb = item / nblk, nb = item % nblk, k0 = 64 * kb, d0 = 32 * nb;
    const int sc = map(d0 + (lane & 31));
#pragma unroll 8
    for (int i = 0; i < 32; ++i) { const int kk = 2 * i + (lane >> 5); scr[kk * 33 + (lane & 31)] = sc >= 0 ? W[(size_t)(k0 + kk) * Nsrc + sc] : 0.f; }
    LDS_WAIT();
    const int c = lane & 7;
#pragma unroll
    for (int j = 0; j < 4; ++j) { const int n = (lane >> 3) + 8 * j; const LAS float* s = scr + (8 * c) * 33 + n;
        v4u o; o.x = pk2(s[0 * 33], s[1 * 33]); o.y = pk2(s[2 * 33], s[3 * 33]); o.z = pk2(s[4 * 33], s[5 * 33]); o.w = pk2(s[6 * 33], s[7 * 33]);
        *(GAS v4u*)(WT + (size_t)(d0 + n) * K + k0 + 8 * c) = o; }
    LDS_WAIT();
}
struct MapIdent { int off; __device__ __forceinline__ int operator()(int d) const { return off + d; } };
struct MapIn {
    __device__ __forceinline__ int operator()(int d) const {
        const int tile = d >> 8, r = d & 255;
        if (tile < 16) { const int seg = tile >> 1; int c = (tile & 1) * 256 + r;
            const int sb = seg == 0 ? 0 : seg == 1 ? 512 : seg == 2 ? 1024 : seg == 3 ? 1536 : seg == 4 ? 2120 : seg == 5 ? 2632 : seg == 6 ? 3144 : 3656;
            if (seg == 0 || seg == 1 || seg == 3) { int hd = c & 63; if (hd < 16) hd = (hd >> 1) + 8 * (hd & 1); c = (c & ~63) | hd; }
            return sb + c; }
        if (tile == 16) { if (r < 64) { int hd = r; if (hd < 16) hd = (hd >> 1) + 8 * (hd & 1); return 2048 + hd; } if (r < 72) return 2112 + (r - 64); return -1; }
        return 4168 + (d - NA);
    }
};
__device__ __forceinline__ void sincos_d(float af, float& s, float& c) {
    const double a = (double)af;
    const double k = __builtin_rint(a * 0.63661977236758134308);
    double r = __builtin_fma(-k, 1.57079632679489655800e+00, a); r = __builtin_fma(-k, 6.12323399573676603587e-17, r);
    const double r2 = r * r;
    double sp = -7.6471637318198164759e-13; sp = sp * r2 + 1.6059043836821614599e-10; sp = sp * r2 - 2.5052108385441718775e-08; sp = sp * r2 + 2.7557319223985890653e-06; sp = sp * r2 - 1.9841269841269841270e-04; sp = sp * r2 + 8.3333333333333333333e-03; sp = sp * r2 - 1.6666666666666666667e-01;
    const double sn = r + r * r2 * sp;
    double cp = 4.7794773323873852974e-14; cp = cp * r2 - 1.1470745597729724714e-11; cp = cp * r2 + 2.0876756987868098979e-09; cp = cp * r2 - 2.7557319223985890653e-07; cp = cp * r2 + 2.4801587301587301587e-05; cp = cp * r2 - 1.3888888888888888889e-03; cp = cp * r2 + 4.1666666666666666667e-02; cp = cp * r2 - 0.5;
    const double cn = 1.0 + r2 * cp;
    const int q = (int)((long long)k & 3);
    const double ss = (q == 0) ? sn : (q == 1) ? cn : (q == 2) ? -sn : -cn;
    const double cc = (q == 0) ? cn : (q == 1) ? -sn : (q == 2) ? -cn : sn;
    s = (float)ss; c = (float)cc;
}

struct Args { const float* in[25]; float* out; unsigned char* ws; int ph_lo, ph_hi; };
typedef __attribute__((address_space(4))) const unsigned char* kptr_t;
__device__ __forceinline__ kptr_t kbase() { kptr_t k = (kptr_t)__builtin_amdgcn_kernarg_segment_ptr(); asm volatile("" : "+s"(k)); return k; }
__device__ __forceinline__ const float* kin(int i) { return *(const float* const __attribute__((address_space(4)))*)(kbase() + 8 * i); }
__device__ __forceinline__ float* kout() { return *(float* const __attribute__((address_space(4)))*)(kbase() + 200); }
__device__ __forceinline__ unsigned char* kws() { return *(unsigned char* const __attribute__((address_space(4)))*)(kbase() + 208); }
static_assert(sizeof(Args) == 224, "Args layout");

__device__ __forceinline__ void norm_phase(const float* xin, float* xout, const bf16* T, const float* gpost, const float* gnext, bf16* O, int mode, int gw, int NGW, int lane) {
    for (int row = gw; row < M; row += NGW) {
        float x[16];
#pragma unroll
        for (int h = 0; h < 2; ++h)
#pragma unroll
            for (int q = 0; q < 2; ++q) { const f32x4 v = *(const GAS f32x4*)(xin + (size_t)row * D + h * 512 + lane * 8 + q * 4); x[h * 8 + q * 4 + 0] = v[0]; x[h * 8 + q * 4 + 1] = v[1]; x[h * 8 + q * 4 + 2] = v[2]; x[h * 8 + q * 4 + 3] = v[3]; }
        if (T) {
            float t[16]; float ss = 0.f;
#pragma unroll
            for (int h = 0; h < 2; ++h) { float a[8]; unpack8(*(const GAS v4u*)(T + (size_t)row * D + h * 512 + lane * 8), a);
#pragma unroll
                for (int k = 0; k < 8; ++k) { t[h * 8 + k] = a[k]; ss += a[k] * a[k]; } }
            const float r = 1.f / sqrtf(wave_sum(ss) * (1.f / D) + EPS);
#pragma unroll
            for (int h = 0; h < 2; ++h)
#pragma unroll
                for (int q = 0; q < 2; ++q) { const f32x4 g = *(const GAS f32x4*)(gpost + h * 512 + lane * 8 + q * 4);
#pragma unroll
                    for (int k = 0; k < 4; ++k) x[h * 8 + q * 4 + k] += t[h * 8 + q * 4 + k] * r * g[k]; }
        }
#pragma unroll
        for (int h = 0; h < 2; ++h)
#pragma unroll
            for (int q = 0; q < 2; ++q) *(GAS f32x4*)(xout + (size_t)row * D + h * 512 + lane * 8 + q * 4) = (f32x4){x[h * 8 + q * 4 + 0], x[h * 8 + q * 4 + 1], x[h * 8 + q * 4 + 2], x[h * 8 + q * 4 + 3]};
        if (mode == 0) {
            float ss = 0.f;
#pragma unroll
            for (int k = 0; k < 16; ++k) ss += x[k] * x[k];
            const float r = 1.f / sqrtf(wave_sum(ss) * (1.f / D) + EPS);
#pragma unroll
            for (int h = 0; h < 2; ++h) { float o[8];
#pragma unroll
                for (int q = 0; q < 2; ++q) { const f32x4 g = *(const GAS f32x4*)(gnext + h * 512 + lane * 8 + q * 4);
#pragma unroll
                    for (int k = 0; k < 4; ++k) o[q * 4 + k] = x[h * 8 + q * 4 + k] * r * g[k]; }
                *(GAS v4u*)(O + (size_t)row * D + h * 512 + lane * 8) = pack8(o); }
        } else if (mode == 1) {
#pragma unroll
            for (int h = 0; h < 2; ++h) { float o[8];
#pragma unroll
                for (int k = 0; k < 8; ++k) o[k] = x[h * 8 + k];
                *(GAS v4u*)(O + (size_t)row * D + h * 512 + lane * 8) = pack8(o); }
        }
    }
}

__device__ __forceinline__ void a1_phase(LAS unsigned char* lds, const bf16* QI, const bf16* KI, const float* WI, bf16* SEL, int gw, int NGW, int wave, int lane) {
    LAS unsigned* sc = (LAS unsigned*)(lds + wave * 18432);
    LAS float* qf = (LAS float*)(lds + wave * 18432 + 16384);
    LAS unsigned* hist = (LAS unsigned*)qf;
    for (int row = gw; row < M; row += NGW) {
        const int t = row & (SEQ - 1), b = row >> 12;
        bf16* selrow = SEL + (size_t)row * 256;
        if (t < 256) {
#pragma unroll
            for (int i = 0; i < 4; ++i) { const int j = lane + 64 * i; selrow[j] = (bf16)(j <= t ? j : 0xFFFF); }
            continue;
        }
        { float q8[8]; unpack8(*(const GAS v4u*)(QI + (size_t)row * 512 + lane * 8), q8);
          *(LAS f32x4*)(qf + lane * 8) = (f32x4){q8[0], q8[1], q8[2], q8[3]}; *(LAS f32x4*)(qf + lane * 8 + 4) = (f32x4){q8[4], q8[5], q8[6], q8[7]}; }
        const f32x4 w0 = *(const GAS f32x4*)(WI + (size_t)row * 8), w1 = *(const GAS f32x4*)(WI + (size_t)row * 8 + 4);
        const float wi[8] = {w0[0], w0[1], w0[2], w0[3], w1[0], w1[1], w1[2], w1[3]};
        LDS_WAIT();
        const int n = t + 1, nch = (n + 63) >> 6;
#pragma unroll 1
        for (int c = 0; c < nch; ++c) {
            asm volatile("" ::: "memory");
            const int s = c * 64 + lane, sl = s < n ? s : n - 1;
            const GAS v4u* kp = (const GAS v4u*)(KI + ((size_t)b * SEQ + sl) * 64);
            float kf[64];
#pragma unroll
            for (int i = 0; i < 8; ++i) { float a[8]; unpack8(kp[i], a);
#pragma unroll
                for (int k = 0; k < 8; ++k) kf[i * 8 + k] = a[k]; }
            float score = 0.f;
#pragma unroll 1
            for (int h = 0; h < 8; ++h) { float d0 = 0.f, d1 = 0.f;
#pragma unroll
                for (int d4 = 0; d4 < 16; ++d4) { const f32x4 qq = *(const LAS f32x4*)(qf + h * 64 + d4 * 4);
                    d0 += qq[0] * kf[d4 * 4 + 0] + qq[2] * kf[d4 * 4 + 2]; d1 += qq[1] * kf[d4 * 4 + 1] + qq[3] * kf[d4 * 4 + 3]; }
                const float wh = h == 0 ? wi[0] : h == 1 ? wi[1] : h == 2 ? wi[2] : h == 3 ? wi[3] : h == 4 ? wi[4] : h == 5 ? wi[5] : h == 6 ? wi[6] : wi[7];
                score += wh * fmaxf(d0 + d1, 0.f); }
            const unsigned ub = __builtin_bit_cast(unsigned, score);
            const unsigned key = (ub & 0x80000000u) ? ~ub : (ub | 0x80000000u);
            if (s < n) sc[s] = key;
        }
        LDS_WAIT();
        unsigned prefix = 0u, pmask = 0u; int need = 256;
#pragma unroll 1
        for (int lvl = 0; lvl < 4; ++lvl) {
            const int shift = 24 - 8 * lvl;
            { unsigned z = 0u; asm volatile("" : "+v"(z)); *(LAS v4u*)(hist + lane * 4) = (v4u){z, z, z, z}; }
            LDS_WAIT();
#pragma unroll 1
            for (int c = 0; c < nch; ++c) { const int s = c * 64 + lane;
                if (s < n) { const unsigned key = sc[s]; if ((key & pmask) == prefix) __hip_atomic_fetch_add(hist + ((key >> shift) & 255u), 1u, __ATOMIC_RELAXED, __HIP_MEMORY_SCOPE_WAVEFRONT); } }
            LDS_WAIT();
            const v4u hc = *(const LAS v4u*)(hist + lane * 4);
            const unsigned tot = hc.x + hc.y + hc.z + hc.w;
            unsigned incl = tot;
#pragma unroll
            for (int o = 1; o < 64; o <<= 1) { const unsigned v = (unsigned)__shfl_down((int)incl, o); if (lane + o < 64) incl += v; }
            unsigned r = incl - tot; int found = -1; unsigned above = 0u;
            const unsigned cn[4] = {hc.x, hc.y, hc.z, hc.w};
#pragma unroll
            for (int k = 3; k >= 0; --k) { if (found < 0 && r < (unsigned)need && r + cn[k] >= (unsigned)need) { found = 4 * lane + k; above = r; } r += cn[k]; }
            const unsigned long long bm = __ballot(found >= 0);
            const int src = bm ? (int)__builtin_ctzll(bm) : 0;
            const int fb = __builtin_amdgcn_readlane(found, src); const unsigned ab = (unsigned)__builtin_amdgcn_readlane((int)above, src);
            need -= (int)ab; prefix |= ((unsigned)fb & 255u) << shift; pmask |= 255u << shift;
            LDS_WAIT();
        }
        int cnt = 0, ties = 0;
#pragma unroll 1
        for (int c = 0; c < nch; ++c) { const int s = c * 64 + lane;
            const unsigned key = s < n ? sc[s] : 0u;
            const bool gt = (s < n) && key > prefix, tie = (s < n) && key == prefix;
            const unsigned long long tb = __ballot(tie);
            const bool take = gt || (tie && (ties + prefix_popc(tb) < need));
            const unsigned long long kb = __ballot(take);
            const int pos = cnt + prefix_popc(kb);
            if (take && pos < 256) selrow[pos] = (bf16)s;
            cnt += __builtin_popcountll(kb); ties += __builtin_popcountll(tb);
        }
        LDS_WAIT();
    }
}

__device__ __forceinline__ void a2_phase(LAS unsigned char* lds, const bf16* Q, const bf16* K, const bf16* V, const bf16* SEL, bf16* YA, int gw, int NGW, int wave, int lane) {
    LAS float* pl = (LAS float*)(lds + wave * 2048);
    LAS int* sl = (LAS int*)(lds + wave * 2048 + 1024);
    for (int row = gw; row < M; row += NGW) {
        const int b = row >> 12;
        int sel[4];
#pragma unroll
        for (int i = 0; i < 4; ++i) { sel[i] = (int)SEL[(size_t)row * 256 + lane + 64 * i]; sl[lane + 64 * i] = sel[i] == 0xFFFF ? 0 : sel[i]; }
        const size_t kb = (size_t)b * SEQ * 512;
#pragma unroll 1
        for (int h = 0; h < 8; ++h) {
            float qf[64];
            { const GAS v4u* qp = (const GAS v4u*)(Q + (size_t)row * 512 + h * 64);
#pragma unroll
              for (int i = 0; i < 8; ++i) { float a[8]; unpack8(qp[i], a);
#pragma unroll
                  for (int k = 0; k < 8; ++k) qf[i * 8 + k] = a[k]; } }
            float lg[4];
#pragma unroll
            for (int i = 0; i < 4; ++i) { const bool valid = sel[i] != 0xFFFF; const int s = valid ? sel[i] : 0;
                const GAS v4u* kp = (const GAS v4u*)(K + kb + (size_t)s * 512 + h * 64);
                float d0 = 0.f, d1 = 0.f;
#pragma unroll
                for (int j = 0; j < 8; ++j) { float a[8]; unpack8(kp[j], a);
#pragma unroll
                    for (int k = 0; k < 8; k += 2) { d0 += a[k] * qf[j * 8 + k]; d1 += a[k + 1] * qf[j * 8 + k + 1]; } }
                lg[i] = valid ? d0 + d1 : -INFINITY; }
            const float mx = wave_max(fmaxf(fmaxf(lg[0], lg[1]), fmaxf(lg[2], lg[3])));
            float p[4], ps = 0.f;
#pragma unroll
            for (int i = 0; i < 4; ++i) { p[i] = __expf(lg[i] - mx); ps += p[i]; }
            const float inv = 1.f / wave_sum(ps);
            LDS_WAIT();
#pragma unroll
            for (int i = 0; i < 4; ++i) pl[lane + 64 * i] = p[i] * inv;
            LDS_WAIT();
            const int g = lane >> 3, dc = lane & 7;
            float acc[8] = {0.f, 0.f, 0.f, 0.f, 0.f, 0.f, 0.f, 0.f};
#pragma unroll 4
            for (int jj = 0; jj < 32; ++jj) { const int j = jj * 8 + g; const float pj = pl[j]; const int sj = sl[j];
                float a[8]; unpack8(*(const GAS v4u*)(V + kb + (size_t)sj * 512 + h * 64 + dc * 8), a);
#pragma unroll
                for (int k = 0; k < 8; ++k) acc[k] += pj * a[k]; }
#pragma unroll
            for (int o = 8; o < 64; o <<= 1)
#pragma unroll
                for (int k = 0; k < 8; ++k) acc[k] += __shfl_xor(acc[k], o);
            if (g == 0) *(GAS v4u*)(YA + (size_t)row * 512 + h * 64 + dc * 8) = pack8(acc);
        }
        LDS_WAIT();
    }
}

template <int PASS>
__device__ __forceinline__ void lru_phase(int layer, const bf16* XR, const bf16* GR, float* AGG, bf16* YB, int blk, int G, int tid) {
    const int c = tid, hb = c >> 6, j = c & 63;
    const float* w_a = kin(7) + ((size_t)(layer * 8 + hb) * 64) * 64 + j;
    const float* w_x = kin(9) + ((size_t)(layer * 8 + hb) * 64) * 64 + j;
    float wa[64], wx[64];
#pragma unroll
    for (int i = 0; i < 64; ++i) { wa[i] = w_a[i * 64]; wx[i] = w_x[i * 64]; }
    const float* cwp = kin(5);
    const float cw0 = cwp[(layer * 4 + 0) * 512 + c], cw1 = cwp[(layer * 4 + 1) * 512 + c], cw2 = cwp[(layer * 4 + 2) * 512 + c], cw3 = cwp[(layer * 4 + 3) * 512 + c];
    const float cb = kin(6)[layer * 512 + c], ba = kin(8)[layer * 512 + c], bx = kin(10)[layer * 512 + c];
    const float lam = kin(11)[layer * 512 + c];
    const float sp8 = 8.f * (fmaxf(-lam, 0.f) + log1pf(__expf(-fabsf(lam))));
    for (int u = blk; u < NB * 32; u += G) {
        const int b = u >> 5, ch = u & 31, row0 = b * SEQ + ch * 128;
        float x0 = 0.f, x1 = 0.f, x2 = 0.f;
        if (ch > 0) { x0 = bf2f(XR[(size_t)(row0 - 3) * 512 + c]); x1 = bf2f(XR[(size_t)(row0 - 2) * 512 + c]); x2 = bf2f(XR[(size_t)(row0 - 1) * 512 + c]); }
        float h = 0.f, P = 1.f;
        if (PASS == 2) { for (int jj = 0; jj < ch; ++jj) { const f32x2 ag = *(const GAS f32x2*)(AGG + ((size_t)(b * 32 + jj) * 512 + c) * 2); h = ag[0] * h + ag[1]; } }
#pragma unroll 1
        for (int t = 0; t < 128; ++t) {
            const float xt = bf2f(XR[(size_t)(row0 + t) * 512 + c]);
            const float xc = cw0 * x0 + cw1 * x1 + cw2 * x2 + cw3 * xt + cb;
            x0 = x1; x1 = x2; x2 = xt;
            float ra = ba, xa = bx;
#pragma unroll
            for (int i = 0; i < 64; ++i) { const float xi = __builtin_bit_cast(float, __builtin_amdgcn_readlane(__builtin_bit_cast(int, xc), i)); ra += xi * wa[i]; xa += xi * wx[i]; }
            const float r = sigm(ra), ig = sigm(xa);
            const float la = -sp8 * r;
            const float a = __expf(la);
            const float y = 2.f * la;
            const float em = -y * (1.f + y * (0.5f + y * (0.16666667f + y * (0.041666668f + y * (0.0083333338f + y * (0.0013888889f + y * 0.0001984127f))))));
            const float inp = sqrtf(fmaxf(em, 0.f)) * (ig * xc);
            h = a * h + inp; P *= a;
            if (PASS == 2) { const float g = bf2f(GR[(size_t)(row0 + t) * 512 + c]); YB[(size_t)(row0 + t) * 512 + c] = (bf16)f2bf(h * g); }
        }
        if (PASS == 1) *(GAS f32x2*)(AGG + ((size_t)u * 512 + c) * 2) = (f32x2){P, h};
    }
}

template <int SMAX>
__device__ __forceinline__ void gmlp_rows(const float* wsp, const float* bsp, const float (&v)[128], int t0, const bf16* ZU, bf16* YC, int row0, int c) {
#pragma unroll 1
    for (int t = t0; t < t0 + 32; ++t) {
        typedef __attribute__((address_space(4))) const f32x4* cf4_t;
        cf4_t wr = (cf4_t)(wsp + t * 128);
        float acc0 = bsp[t], acc1 = 0.f;
#pragma unroll
        for (int s4 = 0; s4 < SMAX / 4; ++s4) { const f32x4 w = wr[s4];
            if (s4 * 4 + 3 < SMAX - 32) { acc0 += w[0] * v[s4 * 4] + w[2] * v[s4 * 4 + 2]; acc1 += w[1] * v[s4 * 4 + 1] + w[3] * v[s4 * 4 + 3]; }
            else {
#pragma unroll
                for (int k = 0; k < 4; ++k) { const float wm = (s4 * 4 + k <= t) ? w[k] : 0.f; acc0 += wm * v[s4 * 4 + k]; } } }
        const float u = bf2f(ZU[(size_t)(row0 + t) * 512 + c]);
        YC[(size_t)(row0 + t) * 512 + c] = (bf16)f2bf(u * (acc0 + acc1));
    }
}
__device__ __forceinline__ void gmlp_phase(LAS unsigned char* lds, int layer, const bf16* ZU, const bf16* ZV, bf16* YC, int blk, int G, int tid, int wave, int lane) {
    LAS float* rms = (LAS float*)lds;
    const int c = tid, g = __builtin_amdgcn_readfirstlane(c >> 6);
    const float gv = kin(12)[layer * 512 + c];
    const float* wsp = kin(13) + (size_t)(layer * 8 + g) * 128 * 128;
    const float* bsp = kin(14) + (size_t)(layer * 8 + g) * 128;
    for (int u = blk; u < NB * 32; u += G) {
        const int row0 = u * 128;
        __syncthreads();
#pragma unroll 1
        for (int i = 0; i < 16; ++i) { const int s = wave * 16 + i; float a[8]; unpack8(*(const GAS v4u*)(ZV + (size_t)(row0 + s) * 512 + lane * 8), a);
            float ss = 0.f;
#pragma unroll
            for (int k = 0; k < 8; ++k) ss += a[k] * a[k];
            ss = wave_sum(ss);
            if (lane == 0) rms[s] = 1.f / sqrtf(ss * (1.f / 512.f) + EPS); }
        __syncthreads();
        float v[128];
#pragma unroll
        for (int s = 0; s < 128; ++s) v[s] = bf2f(ZV[(size_t)(row0 + s) * 512 + c]) * rms[s] * gv;
        gmlp_rows<32>(wsp, bsp, v, 0, ZU, YC, row0, c);
        gmlp_rows<64>(wsp, bsp, v, 32, ZU, YC, row0, c);
        gmlp_rows<96>(wsp, bsp, v, 64, ZU, YC, row0, c);
        gmlp_rows<128>(wsp, bsp, v, 96, ZU, YC, row0, c);
    }
}

#define IN(k) (lo <= (k) && (k) < hi)
#define SEAM(k) do { if (IN(k) && IN((k) + 1)) xcd_barrier(bar); } while (0)
#define WP(T, off) ((T*)(ws + (off)))
#define PH_LOCAL() int G = gridDim.x, blk = blockIdx.x; asm volatile("" : "+s"(G), "+s"(blk)); const int NGW = G * NWAVES; int tid = wave0 * 64 + lane_id(); asm volatile("" : "+v"(tid)); \
    const int lane = tid & 63, wave = __builtin_amdgcn_readfirstlane(tid >> 6), gw = blk * NWAVES + wave; (void)lane; (void)gw; (void)NGW
template <int layer>
__device__ __forceinline__ void layer_body(LAS unsigned char* lds, const XcdBarrier& bar, const int lo, const int hi, const int wave0) {
        const int pb = 1 + layer * PH_PER_LAYER;
#define WL(off) ((const bf16*)(ws + WS_W + (size_t)layer * W_LAYER + (off)))

        if (IN(pb + 0)) {
            unsigned char* ws = kws(); PH_LOCAL();
            pg8::Gemm g{WP(bf16, WS_H), WL(WO_IN), M, NA, D}; pg8::StaticOrder S; S.init(M, NA, G, blk);
            pg8::EpiInA E{WP(bf16, WS_Q), WP(bf16, WS_K), WP(bf16, WS_V), WP(bf16, WS_QI), WP(bf16, WS_XR), WP(bf16, WS_GR), WP(bf16, WS_ZU), WP(bf16, WS_ZV), WP(bf16, WS_KI), WP(float, WS_WI), WP(float, WS_ROPE)};
            pg8::gemm_phase<pg8::EpiInA, pg8::StaticOrder, true, true>(lds, g, S, E, wave0);
        }
        SEAM(pb + 0);
        if (IN(pb + 1)) {
            unsigned char* ws = kws(); PH_LOCAL();
#ifndef DBG_NOA
            a1_phase(lds, WP(bf16, WS_QI), WP(bf16, WS_KI), WP(float, WS_WI), WP(bf16, WS_SEL), gw, NGW, wave, lane);
#endif
            __syncthreads();
#ifndef DBG_NOB
            lru_phase<1>(layer, WP(bf16, WS_XR), WP(bf16, WS_GR), WP(float, WS_AGG), WP(bf16, WS_ZU), blk, G, tid);
#endif
            __syncthreads();
#ifndef DBG_NOC
            gmlp_phase(lds, layer, WP(bf16, WS_ZU), WP(bf16, WS_ZV), WP(bf16, WS_YC), blk, G, tid, wave, lane);
#else
            zero_rows(WP(bf16, WS_YC), blk, G, tid);
#endif
        }
        SEAM(pb + 1);
        if (IN(pb + 2)) {
            unsigned char* ws = kws(); PH_LOCAL();
            __syncthreads();
#ifndef DBG_NOA
            a2_phase(lds, WP(bf16, WS_Q), WP(bf16, WS_K), WP(bf16, WS_V), WP(bf16, WS_SEL), WP(bf16, WS_QI), gw, NGW, wave, lane);
#else
            zero_rows(WP(bf16, WS_QI), blk, G, tid);
#endif
            __syncthreads();
#ifndef DBG_NOB
            lru_phase<2>(layer, WP(bf16, WS_XR), WP(bf16, WS_GR), WP(float, WS_AGG), WP(bf16, WS_ZU), blk, G, tid);
#else
            zero_rows(WP(bf16, WS_ZU), blk, G, tid);
#endif
        }
        SEAM(pb + 2);
        if (IN(pb + 3)) {
            unsigned char* ws = kws(); PH_LOCAL();
            pg8::Gemm g{WP(bf16, WS_H), WL(WO_IN) + (size_t)NA * D, M, NG, D}; pg8::StaticOrder S; S.init(M, NG, G, blk);
            pg8::EpiGen<2> E{WP(bf16, WS_G), NG, nullptr};
            pg8::gemm_phase<pg8::EpiGen<2>, pg8::StaticOrder, true, true>(lds, g, S, E, wave0);
        }
        SEAM(pb + 3);
        if (IN(pb + 4)) {
            unsigned char* ws = kws(); PH_LOCAL();
            pg8::Gemm g{WP(bf16, WS_QI), WL(WO_BR), 3 * M, 3 * D, 512}; pg8::MergeOrder S; S.so.init(M, D, G, blk);
            pg8::EpiMerge E{WP(bf16, WS_H), WP(bf16, WS_G)};
            pg8::gemm_phase<pg8::EpiMerge, pg8::MergeOrder, true, true>(lds, g, S, E, wave0);
        }
        SEAM(pb + 4);
        if (IN(pb + 5)) {
            unsigned char* ws = kws(); PH_LOCAL();
            pg8::Gemm g{WP(bf16, WS_H), WL(WO_OUT), M, D, D}; pg8::StaticOrder S; S.init(M, D, G, blk);
            pg8::EpiGen<0> E{WP(bf16, WS_T), D, nullptr};
            pg8::gemm_phase<pg8::EpiGen<0>, pg8::StaticOrder, true, true>(lds, g, S, E, wave0);
        }
        SEAM(pb + 5);
        if (IN(pb + 6)) { unsigned char* ws = kws(); PH_LOCAL();  float* X = kout(); norm_phase(X, X, WP(bf16, WS_T), kin(17) + layer * D, kin(18) + layer * D, WP(bf16, WS_H), 0, gw, NGW, lane); }
        SEAM(pb + 6);
        if (IN(pb + 7)) {
            unsigned char* ws = kws(); PH_LOCAL();
            pg8::Gemm g{WP(bf16, WS_H), WL(WO_UP), M, FF, D}; pg8::StaticOrder S; S.init(M, FF, G, blk);
            pg8::EpiGen<1> E{WP(bf16, WS_U), FF, nullptr};
            pg8::gemm_phase<pg8::EpiGen<1>, pg8::StaticOrder, true, true>(lds, g, S, E, wave0);
        }
        SEAM(pb + 7);
        if (IN(pb + 8)) {
            unsigned char* ws = kws(); PH_LOCAL();
            pg8::Gemm g{WP(bf16, WS_U), WL(WO_DN), M, D, FF}; pg8::StaticOrder S; S.init(M, D, G, blk);
            pg8::EpiGen<0> E{WP(bf16, WS_T2), D, nullptr};
#ifndef DBG_NOF
            pg8::gemm_phase<pg8::EpiGen<0>, pg8::StaticOrder, true, true>(lds, g, S, E, wave0);
#else
            { const int tid = wave0 * 64 + lane_id(); for (size_t e = (size_t)(blk * 512 + tid) * 8; e < (size_t)M * D; e += (size_t)G * 512 * 8) *(GAS v4u*)(WP(bf16, WS_T2) + e) = (v4u){0u, 0u, 0u, 0u}; }
#endif
        }
        SEAM(pb + 8);
        if (IN(pb + 9)) { unsigned char* ws = kws(); PH_LOCAL();  float* X = kout(); norm_phase(X, X, WP(bf16, WS_T2), kin(21) + layer * D, nullptr, WP(bf16, WS_H), 1, gw, NGW, lane); }
        SEAM(pb + 9);
        if (IN(pb + 10)) {
            unsigned char* ws = kws(); PH_LOCAL();
            pg8::Gemm g{WP(bf16, WS_H), WL(WO_PG), M, D, D}; pg8::StaticOrder S; S.init(M, D, G, blk);
#ifdef DBG_S0
            zero_rows(WP(bf16, WS_S), blk, G, wave0 * 64 + lane_id()); zero_rows(WP(bf16, WS_S) + (size_t)M * 512, blk, G, wave0 * 64 + lane_id());
#else
#ifdef DBG_S2T
            pg8::EpiGen<2> E{WP(bf16, WS_T3), D, nullptr};
#else
            pg8::EpiGen<2> E{WP(bf16, WS_S), D, nullptr};
#endif
            pg8::gemm_phase<pg8::EpiGen<2>, pg8::StaticOrder, true, true>(lds, g, S, E, wave0);
#endif
        }
        SEAM(pb + 10);
        if (IN(pb + 11)) {
            unsigned char* ws = kws(); PH_LOCAL();
            pg8::Gemm g{WP(bf16, WS_P) + (size_t)layer * M * PLE, WL(WO_PLE), M, D, PLE}; pg8::StaticOrder S; S.init(M, D, G, blk);
#ifdef DBG_S2T
#elif defined(DBG_P0)
            pg8::EpiGen<0> E{WP(bf16, WS_T3), D, WP(bf16, WS_S)};
            pg8::gemm_phase<pg8::EpiGen<0>, pg8::StaticOrder, true, true>(lds, g, S, E, wave0);
#elif !defined(DBG_NOP)
            pg8::EpiGen<3> E{WP(bf16, WS_T3), D, WP(bf16, WS_S)};
            pg8::gemm_phase<pg8::EpiGen<3>, pg8::StaticOrder, true, true>(lds, g, S, E, wave0);
#else
            { const int tid = wave0 * 64 + lane_id(); for (size_t e = (size_t)(blk * 512 + tid) * 8; e < (size_t)M * D; e += (size_t)G * 512 * 8) *(GAS v4u*)(WP(bf16, WS_T3) + e) = (v4u){0u, 0u, 0u, 0u}; }
#endif
        }
        SEAM(pb + 11);
        if (IN(pb + 12)) {
            unsigned char* ws = kws(); PH_LOCAL();  float* X = kout();
            if (layer + 1 < NLAYER) norm_phase(X, X, WP(bf16, WS_T3), kin(24) + layer * D, kin(3) + (layer + 1) * D, WP(bf16, WS_H), 0, gw, NGW, lane);
            else norm_phase(X, X, WP(bf16, WS_T3), kin(24) + layer * D, nullptr, WP(bf16, WS_H), 2, gw, NGW, lane);
        }
        SEAM(pb + 12);
    }

__global__ void __launch_bounds__(NWAVES * 64, 2) fwd(Args args) {
    extern __shared__ __attribute__((aligned(16))) unsigned char lds_raw[];
    LAS unsigned char* lds = (LAS unsigned char*)lds_raw;
    volatile LAS unsigned* MISC = (volatile LAS unsigned*)(lds + MISC_OFF);
    const int wave0 = __builtin_amdgcn_readfirstlane((int)(threadIdx.x >> 6));
    if (wave0 == 0) { const int l = lane_id(); if (l < 32) MISC[l] = 0u; }
    __syncthreads();
    const int lo = args.ph_lo, hi = args.ph_hi;
    XcdBarrier bar; bar.bar = (unsigned*)(kws() + WS_CTL) + CW_BAR; bar.x = 0; bar.st = nullptr; bar.w0 = wave0;
    if (hi - lo > 1) bar = xcd_barrier_post((unsigned*)(kws() + WS_CTL) + CW_BAR, MISC + 8, wave0);

    if (IN(0)) {
        unsigned char* ws = kws(); PH_LOCAL();
        LAS float* scr = (LAS float*)(lds + wave * 16384);
        constexpr int I_IN = 16 * (NIN / 32), I_BR = 8 * 32, I_OUT = 16 * 32, I_UP = 16 * 128, I_DN = 64 * 32, I_PLE = 4 * 32, I_PG = 16 * 32;
        constexpr int I_LAYER = I_IN + 3 * I_BR + I_OUT + I_UP + I_DN + I_PLE + I_PG;
        for (int it = gw; it < NLAYER * I_LAYER; it += NGW) {
            const int layer = it / I_LAYER; int r = it % I_LAYER;
            unsigned char* wl = ws + WS_W + (size_t)layer * W_LAYER;
            if (r < I_IN) { transpose_item(kin(4) + (size_t)layer * D * INW, D, INW, (bf16*)(wl + WO_IN), NIN / 32, scr, r, lane, MapIn{}); continue; } r -= I_IN;
            if (r < 3 * I_BR) { const int n = r / I_BR; transpose_item(kin(15) + ((size_t)layer * 3 + n) * 512 * D, 512, D, (bf16*)(wl + WO_BR) + (size_t)n * D * 512, D / 32, scr, r % I_BR, lane, MapIdent{0}); continue; } r -= 3 * I_BR;
            if (r < I_OUT) { transpose_item(kin(16) + (size_t)layer * D * D, D, D, (bf16*)(wl + WO_OUT), D / 32, scr, r, lane, MapIdent{0}); continue; } r -= I_OUT;
            if (r < I_UP) { transpose_item(kin(19) + (size_t)layer * D * FF, D, FF, (bf16*)(wl + WO_UP), FF / 32, scr, r, lane, MapIdent{0}); continue; } r -= I_UP;
            if (r < I_DN) { transpose_item(kin(20) + (size_t)layer * FF * D, FF, D, (bf16*)(wl + WO_DN), D / 32, scr, r, lane, MapIdent{0}); continue; } r -= I_DN;
            if (r < I_PLE) { transpose_item(kin(22) + (size_t)layer * PLE * D, PLE, D, (bf16*)(wl + WO_PLE), D / 32, scr, r, lane, MapIdent{0}); continue; } r -= I_PLE;
            transpose_item(kin(23) + (size_t)layer * D * D, D, D, (bf16*)(wl + WO_PG), D / 32, scr, r, lane, MapIdent{0});
        }
        { const int* pos = (const int*)kin(2); float* rope = WP(float, WS_ROPE);
          for (int e = blk * 512 + tid; e < M * 8; e += G * 512) { const int row = e >> 3, jf = e & 7;
              const float invf = jf == 0 ? 1.0f : jf == 1 ? 0.1939227432012558f : jf == 2 ? 0.03760603070259094f : jf == 3 ? 0.007292664609849453f : jf == 4 ? 0.0014142135623842478f : jf == 5 ? 0.00027424818836152554f : jf == 6 ? 5.318296098266728e-05f : 1.0313386155758053e-05f;
              const float ang = (float)pos[row] * invf; float s, c; sincos_d(ang, s, c);
              *(GAS f32x2*)(rope + (size_t)row * 16 + jf * 2) = (f32x2){c, s}; } }
        { const float* p = kin(1); bf16* Pb = WP(bf16, WS_P);
          for (size_t e = (size_t)(blk * 512 + tid) * 8; e < (size_t)NLAYER * M * PLE; e += (size_t)G * 512 * 8) {
              const f32x4 a = *(const GAS f32x4*)(p + e), b2 = *(const GAS f32x4*)(p + e + 4);
              const float o[8] = {a[0], a[1], a[2], a[3], b2[0], b2[1], b2[2], b2[3]};
              *(GAS v4u*)(Pb + e) = pack8(o); } }
        norm_phase(kin(0), kout(), nullptr, nullptr, kin(3), WP(bf16, WS_H), 0, gw, NGW, lane);
    }
    SEAM(0);

    layer_body<0>(lds, bar, lo, hi, wave0);
    layer_body<1>(lds, bar, lo, hi, wave0);
#undef IN
#undef SEAM
}

extern "C" void kernel_launch(void* const* d_in, const int* in_sizes, int n_in, void* d_out, int out_size, void* d_ws, size_t ws_size, hipStream_t stream) {
    static int grid = 0;
    if (grid == 0) {
        if (n_in != 25 || in_sizes[0] != M * D || out_size != M * D || ws_size < WS_END) { fprintf(stderr, "kernel_launch: unexpected shapes: n_in %d in0 %d out %d ws %zu (need %zu)\n", n_in, n_in > 0 ? in_sizes[0] : -1, out_size, ws_size, (size_t)WS_END); grid = -1; return; }
        int dev = 0, cus = 0, per_cu = 0;
        if (hipGetDevice(&dev) != hipSuccess || hipDeviceGetAttribute(&cus, hipDeviceAttributeMultiprocessorCount, dev) != hipSuccess) { grid = -1; return; }
        if (hipFuncSetAttribute((const void*)fwd, hipFuncAttributeMaxDynamicSharedMemorySize, LDS_BYTES) != hipSuccess) { fprintf(stderr, "kernel_launch: hipFuncSetAttribute failed\n"); grid = -1; return; }
        if (hipOccupancyMaxActiveBlocksPerMultiprocessor(&per_cu, (const void*)fwd, NWAVES * 64, LDS_BYTES) != hipSuccess || per_cu < 1) { fprintf(stderr, "kernel_launch: occupancy query reports %d\n", per_cu); }
        (void)hipGetLastError();
        grid = cus;
    }
    if (grid < 0) return;
    if (hipMemsetAsync((char*)d_ws + WS_CTL, 0, CTL_ZERO_BYTES, stream) != hipSuccess) return;
    Args a{};
    for (int i = 0; i < 25; ++i) a.in[i] = (const float*)d_in[i];
    a.out = (float*)d_out; a.ws = (unsigned char*)d_ws;
#if MK_ONE_LAUNCH
    a.ph_lo = 0; a.ph_hi = NPH;
    hipLaunchKernelGGL(fwd, dim3(grid), dim3(NWAVES * 64), LDS_BYTES, stream, a);
#else
    for (int ph = 0; ph < NPH; ++ph) { a.ph_lo = ph; a.ph_hi = ph + 1; hipLaunchKernelGGL(fwd, dim3(grid), dim3(NWAVES * 64), LDS_BYTES, stream, a); }
#endif
}
```

```cpp
#include <hip/hip_runtime.h>
#include <cstdio>
#include <cstdint>
namespace pg8 {
#define PG8_LAS __attribute__((address_space(3)))
typedef unsigned short bf16_t;
typedef short bf16x8 __attribute__((ext_vector_type(8)));
typedef float f32x4 __attribute__((ext_vector_type(4)));
typedef unsigned u32x4 __attribute__((ext_vector_type(4)));
constexpr int BM = 256, BK = 64, HALF = 128, HTB = HALF * BK * 2  , STAGE_BYTES = 8 * HTB, NXCD = 8, WGM = 8;

__host__ __device__ __forceinline__ int lds_byte(int r, int c) { const int st = (r >> 4) * 2 + (c >> 5), rr = r & 15, cc = c & 31, ob = rr * 64 + cc * 2; return st * 1024 + (ob ^ (((ob >> 9) & 1) << 5)); }
__host__ __device__ __forceinline__ void stage_rc(int b, int& R, int& C) { const int st = b / 1024, sb = b % 1024, swz = sb ^ (((sb >> 9) & 1) << 5); R = (st >> 1) * 16 + swz / 64; C = (st & 1) * 32 + (swz % 64) / 2; }
__host__ __device__ __forceinline__ int perm32(int rho) { const int n = rho >> 4, i = rho & 15; return 8 * (i >> 2) + 4 * n + (i & 3); }

struct Unit { int pm, pn; };
struct Gemm { const bf16_t* A; const bf16_t* Bt; int M, N, K; };

struct StaticOrder {
    int nM, nN, nwg, G, c;
    __host__ __device__ void init(int M, int N, int G_, int c_) { nM = M / BM; nN = N / BM; nwg = nM * nN; G = G_; c = c_; }
    __host__ __device__ bool next(int i, Unit& u) const {
        const long L = (long)i * G + c; if (L >= nwg) return false;
        int wgid = (int)L; { const int q = nwg / NXCD, r = nwg % NXCD, xcd = wgid % NXCD, off = wgid / NXCD; wgid = (xcd < r ? xcd * (q + 1) : r * (q + 1) + (xcd - r) * q) + off; }
        const int nig = WGM * nN, gid = wgid / nig, fm = gid * WGM, gsz = (nM - fm) < WGM ? (nM - fm) : WGM;
        u.pm = fm + ((wgid % nig) % gsz); u.pn = (wgid % nig) / gsz; return true;
    }
    __device__ __forceinline__ void a_ready(const Unit&) const {}
    __device__ __forceinline__ void done(const Unit&) const {}
};


typedef float f32x2_t __attribute__((ext_vector_type(2))); typedef __bf16 bf16x2_t __attribute__((ext_vector_type(2)));
__device__ __forceinline__ unsigned cvt_pk_bf16(float lo, float hi) { f32x2_t v = {lo, hi}; bf16x2_t b = __builtin_convertvector(v, bf16x2_t); return __builtin_bit_cast(unsigned, b); }
__device__ __forceinline__ float bflo(unsigned w) { return __builtin_bit_cast(float, w << 16); }
__device__ __forceinline__ float bfhi(unsigned w) { return __builtin_bit_cast(float, w & 0xffff0000u); }
__device__ __forceinline__ float fexp(float x) { return __builtin_amdgcn_exp2f(x * 1.4426950408889634f); }
__device__ __forceinline__ float sigm(float x) { return __builtin_amdgcn_rcpf(1.f + fexp(-x)); }
__device__ __forceinline__ float gelu_tanh(float x) { const float u = 0.7978845608028654f * (x + 0.044715f * x * x * x); return x * __builtin_amdgcn_rcpf(1.f + fexp(-2.f * u)); }
__device__ __forceinline__ void unpack8(const u32x4 a, float (&v)[8]) { v[0] = bflo(a.x); v[1] = bfhi(a.x); v[2] = bflo(a.y); v[3] = bfhi(a.y); v[4] = bflo(a.z); v[5] = bfhi(a.z); v[6] = bflo(a.w); v[7] = bfhi(a.w); }
__device__ __forceinline__ u32x4 pack8(const float (&v)[8]) { u32x4 w; w.x = cvt_pk_bf16(v[0], v[1]); w.y = cvt_pk_bf16(v[2], v[3]); w.z = cvt_pk_bf16(v[4], v[5]); w.w = cvt_pk_bf16(v[6], v[7]); return w; }

template <int MODE  > struct EpiGen {
    static constexpr bool PERM = true, AFTER_DRAIN = false, CHAIN = false;
    bf16_t* O; int ldc; const bf16_t* aux;
    __device__ __forceinline__ void operator()(const f32x4 (&acc)[2][2][4][2], const Unit& u, int wr, int wc, int fr, int fq) const {
        const int row0 = u.pm * BM + wr * 64 + fr, col0 = u.pn * BM + wc * 32 + 8 * fq;
#pragma unroll
        for (int ai = 0; ai < 2; ++ai) {
            u32x4 ax[4][2];
            if (MODE == 3) {
#pragma unroll
                for (int m = 0; m < 4; ++m)
#pragma unroll
                    for (int bj = 0; bj < 2; ++bj) ax[m][bj] = *(const u32x4*)(aux + (size_t)(row0 + ai * HALF + m * 16) * ldc + col0 + bj * HALF); }
#pragma unroll
            for (int m = 0; m < 4; ++m) { const size_t ro = (size_t)(row0 + ai * HALF + m * 16) * ldc + col0;
#pragma unroll
                for (int bj = 0; bj < 2; ++bj) { const f32x4 v0 = acc[ai][bj][m][0], v1 = acc[ai][bj][m][1];
                    float v[8] = {v0[0], v0[1], v0[2], v0[3], v1[0], v1[1], v1[2], v1[3]};
                    if (MODE == 1) {
#pragma unroll
                        for (int k = 0; k < 8; ++k) { const float r = fmaxf(v[k], 0.f); v[k] = r * r; } }
                    if (MODE == 2) {
#pragma unroll
                        for (int k = 0; k < 8; ++k) v[k] = sigm(v[k]); }
                    if (MODE == 4) {
#pragma unroll
                        for (int k = 0; k < 8; ++k) v[k] = fmaxf(sigm(v[k]), 6.103515625e-05f); }
                    if (MODE == 3) { float a[8]; unpack8(ax[m][bj], a);
#pragma unroll
                        for (int k = 0; k < 8; ++k) v[k] *= a[k]; }
                    *(u32x4*)(O + ro + bj * HALF) = pack8(v); } }
            if (MODE == 3) __builtin_amdgcn_sched_barrier(0); }
    }
};

struct EpiInA {
    static constexpr bool PERM = true, AFTER_DRAIN = false, CHAIN = false;
    bf16_t *Q, *Kb, *V, *QI, *XR, *GR, *ZU, *ZV, *KI; float* WI; const float* rope;
    __device__ __forceinline__ void operator()(const f32x4 (&acc)[2][2][4][2], const Unit& u, int wr, int wc, int fr, int fq) const {
        const int pn = u.pn, seg = pn >> 1;
        const int row0 = u.pm * BM + wr * 64 + fr, ct0 = wc * 32 + 8 * fq;
        const bool ropelane = ((wc & 1) == 0) && (fq < 2);
        if (pn < 16) {
            bf16_t* dst = seg == 0 ? Q : seg == 1 ? Kb : seg == 2 ? V : seg == 3 ? QI : seg == 4 ? XR : seg == 5 ? GR : seg == 6 ? ZU : ZV;
            const bool dorope = (seg == 0 || seg == 1 || seg == 3) && ropelane;
            const bool dogelu = seg >= 5;
            const float sc = (seg == 0) ? 0.18033688011112042f : 1.f;
#pragma unroll
            for (int ai = 0; ai < 2; ++ai) {
                f32x4 csa[4], csb[4];
#pragma unroll
                for (int m = 0; m < 4; ++m) { csa[m] = (f32x4){1.f, 0.f, 1.f, 0.f}; csb[m] = csa[m];
                    if (dorope) { const float* rp = rope + (size_t)(row0 + ai * HALF + m * 16) * 16 + fq * 8; csa[m] = *(const f32x4*)rp; csb[m] = *(const f32x4*)(rp + 4); } }
#pragma unroll
                for (int m = 0; m < 4; ++m) { const int row = row0 + ai * HALF + m * 16;
                    const f32x4 cs0 = csa[m], cs1 = csb[m];
#pragma unroll
                    for (int bj = 0; bj < 2; ++bj) { const f32x4 v0 = acc[ai][bj][m][0], v1 = acc[ai][bj][m][1];
                        float v[8] = {v0[0], v0[1], v0[2], v0[3], v1[0], v1[1], v1[2], v1[3]};
                        if (dorope) { const float c[4] = {cs0[0], cs0[2], cs1[0], cs1[2]}, s[4] = {cs0[1], cs0[3], cs1[1], cs1[3]};
#pragma unroll
                            for (int i = 0; i < 4; ++i) { const float x1 = v[2 * i], x2 = v[2 * i + 1]; v[2 * i] = x1 * c[i] - x2 * s[i]; v[2 * i + 1] = x2 * c[i] + x1 * s[i]; } }
                        if (dogelu) {
#pragma unroll
                            for (int k = 0; k < 8; ++k) v[k] = gelu_tanh(v[k]); }
#pragma unroll
                        for (int k = 0; k < 8; ++k) v[k] *= sc;
                        *(u32x4*)(dst + (size_t)row * 512 + (pn & 1) * 256 + bj * HALF + ct0) = pack8(v); } } }
        } else {
#pragma unroll
            for (int ai = 0; ai < 2; ++ai)
#pragma unroll
                for (int m = 0; m < 4; ++m) { const int row = row0 + ai * HALF + m * 16;
                    const f32x4 v0 = acc[ai][0][m][0], v1 = acc[ai][0][m][1];
                    float v[8] = {v0[0], v0[1], v0[2], v0[3], v1[0], v1[1], v1[2], v1[3]};
                    if (wc < 2) {
                        if (wc == 0 && fq < 2) { const f32x4 cs0 = *(const f32x4*)(rope + (size_t)row * 16 + fq * 8), cs1 = *(const f32x4*)(rope + (size_t)row * 16 + fq * 8 + 4);
                            const float c[4] = {cs0[0], cs0[2], cs1[0], cs1[2]}, s[4] = {cs0[1], cs0[3], cs1[1], cs1[3]};
#pragma unroll
                            for (int i = 0; i < 4; ++i) { const float x1 = v[2 * i], x2 = v[2 * i + 1]; v[2 * i] = x1 * c[i] - x2 * s[i]; v[2 * i + 1] = x2 * c[i] + x1 * s[i]; } }
                        *(u32x4*)(KI + (size_t)row * 64 + ct0) = pack8(v);
                    } else if (wc == 2 && fq == 0) {
                        const float is = 0.04419417382415922f;
                        *(f32x4*)(WI + (size_t)row * 8) = (f32x4){v[0] * is, v[1] * is, v[2] * is, v[3] * is};
                        *(f32x4*)(WI + (size_t)row * 8 + 4) = (f32x4){v[4] * is, v[5] * is, v[6] * is, v[7] * is};
                    } }
        }
    }
};

struct EpiMerge {
    static constexpr bool PERM = true, AFTER_DRAIN = false, CHAIN = false;
    bf16_t* Mg; const bf16_t* G;
    __device__ __forceinline__ void operator()(const f32x4 (&acc)[2][2][4][2], const Unit& u, int wr, int wc, int fr, int fq) const {
        const int n = u.pm >> 7, pm = u.pm & 127, pn = u.pn & 3;
        const int row0 = pm * BM + wr * 64 + fr, col0 = pn * BM + wc * 32 + 8 * fq;
#pragma unroll
        for (int ai = 0; ai < 2; ++ai)
#pragma unroll
            for (int m = 0; m < 4; ++m) { const int row = row0 + ai * HALF + m * 16;
#pragma unroll
                for (int bj = 0; bj < 2; ++bj) { const int col = col0 + bj * HALF; const f32x4 v0 = acc[ai][bj][m][0], v1 = acc[ai][bj][m][1];
                    float v[8] = {v0[0], v0[1], v0[2], v0[3], v1[0], v1[1], v1[2], v1[3]}, g[8];
                    unpack8(*(const u32x4*)(G + (size_t)row * 3072 + n * 1024 + col), g);
#pragma unroll
                    for (int k = 0; k < 8; ++k) v[k] *= g[k];
                    bf16_t* op = Mg + (size_t)row * 1024 + col;
                    if (n > 0) { float o[8]; unpack8(*(const u32x4*)op, o);
#pragma unroll
                        for (int k = 0; k < 8; ++k) v[k] += o[k]; }
                    *(u32x4*)op = pack8(v); __builtin_amdgcn_sched_barrier(0); } }
    }
};
struct EpiMerge2 {
    static constexpr bool PERM = true, AFTER_DRAIN = false, CHAIN = true;
    bf16_t* Mg; const bf16_t* G;
    __device__ __forceinline__ bool keep(const Unit& u) const { return (u.pm >> 7) < 2; }
    __device__ __forceinline__ void operator()(f32x4 (&acc)[2][2][4][2], const Unit& u, int wr, int wc, int fr, int fq) const {
        const int n = u.pm >> 7, pm = u.pm & 127, pn = u.pn & 3;
        const int row0 = pm * BM + wr * 64 + fr, col0 = pn * BM + wc * 32 + 8 * fq;
#pragma unroll
        for (int ai = 0; ai < 2; ++ai)
#pragma unroll
            for (int mp = 0; mp < 2; ++mp) {
                u32x4 ga[2][2], gb[2][2];
#pragma unroll
                for (int mm = 0; mm < 2; ++mm)
#pragma unroll
                    for (int bj = 0; bj < 2; ++bj) { const bf16_t* gp = G + (size_t)(row0 + ai * HALF + (2 * mp + mm) * 16) * 3072 + col0 + bj * HALF;
                        ga[mm][bj] = *(const u32x4*)(gp + n * 1024); gb[mm][bj] = n < 2 ? *(const u32x4*)(gp + (n + 1) * 1024) : ga[mm][bj]; }
#pragma unroll
                for (int mm = 0; mm < 2; ++mm)
#pragma unroll
                    for (int bj = 0; bj < 2; ++bj) { const int m = 2 * mp + mm; float g[8]; unpack8(ga[mm][bj], g);
                        if (n < 2) { float h[8]; unpack8(gb[mm][bj], h);
#pragma unroll
                            for (int k = 0; k < 8; ++k) g[k] *= __builtin_amdgcn_rcpf(h[k]);
                            acc[ai][bj][m][0] *= (f32x4){g[0], g[1], g[2], g[3]}; acc[ai][bj][m][1] *= (f32x4){g[4], g[5], g[6], g[7]};
                        } else {
                            const f32x4 v0 = acc[ai][bj][m][0] * (f32x4){g[0], g[1], g[2], g[3]}, v1 = acc[ai][bj][m][1] * (f32x4){g[4], g[5], g[6], g[7]};
                            const float v[8] = {v0[0], v0[1], v0[2], v0[3], v1[0], v1[1], v1[2], v1[3]};
                            *(u32x4*)(Mg + (size_t)(row0 + ai * HALF + m * 16) * 1024 + col0 + bj * HALF) = pack8(v); } }
                __builtin_amdgcn_sched_barrier(0); }
    }
};
struct MergeOrder {
    StaticOrder so;
    __device__ bool next(int i, Unit& u) const { const int n = i % 3; Unit t; if (!so.next(i / 3, t)) return false; u.pm = n * 128 + t.pm; u.pn = n * 4 + t.pn; return true; }
    __device__ __forceinline__ void a_ready(const Unit&) const {}
    __device__ __forceinline__ void done(const Unit&) const {}
};

template <class Epi, class Sched, bool ALIGN_EPI = false, bool SP2 = false>
__device__ __forceinline__ void gemm_phase(PG8_LAS unsigned char* lds, const Gemm g, const Sched& S, const Epi& E, const int wave_id) {
    int tid_; asm volatile("v_mbcnt_lo_u32_b32 %0, -1, 0\n\tv_mbcnt_hi_u32_b32 %0, -1, %0" : "=v"(tid_)); tid_ += wave_id * 64; asm volatile("" : "+v"(tid_));
    const int tid = tid_, wid = __builtin_amdgcn_readfirstlane(tid >> 6), lane = tid & 63, wr = wid >> 2, wc = wid & 3, fr = lane & 15, fq = lane >> 4;
    const int K = g.K, nt = K / BK;
    unsigned voffA[2], voffB[2];
#pragma unroll
    for (int i = 0; i < 2; ++i) { int R, C; stage_rc(tid * 16 + i * 8192, R, C); const int Rb = Epi::PERM ? ((R & ~31) + perm32(R & 31)) : R;
        voffA[i] = (unsigned)(R * K + C) * 2u; voffB[i] = (unsigned)(Rb * K + C) * 2u; }
    const size_t kstep = (size_t)(BK * 2);
    const size_t hstep = (size_t)HALF * K * 2;
    const size_t tstep = 2 * hstep;
    const unsigned ldsw = (unsigned)wid * 1024u;
    const int aoff = lds_byte(wr * 64 + fr, fq * 8), boff = lds_byte(wc * 32 + fr, fq * 8);
#define PG8_SA(b, h) (((b) * 2 + (h)) * HTB)
#define PG8_SB(b, h) ((4 + (b) * 2 + (h)) * HTB)
#define PG8_STAGE(bufoff, gbase, voff) do { _Pragma("unroll") for (int _i = 0; _i < 2; ++_i) \
        __builtin_amdgcn_global_load_lds((const unsigned*)((const char*)(gbase) + (voff)[_i]), (PG8_LAS unsigned*)(lds + (bufoff) + ldsw + _i * 8192), 16, 0, 0); } while (0)
#define PG8_LDA(dst, b, h) do { _Pragma("unroll") for (int m = 0; m < 4; ++m) _Pragma("unroll") for (int k = 0; k < 2; ++k) dst[m][k] = *(const PG8_LAS bf16x8*)(lds + PG8_SA(b, h) + aoff + m * 2048 + k * 1024); } while (0)
#define PG8_LDB(dst, b, h) do { _Pragma("unroll") for (int n = 0; n < 2; ++n) _Pragma("unroll") for (int k = 0; k < 2; ++k) dst[n][k] = *(const PG8_LAS bf16x8*)(lds + PG8_SB(b, h) + boff + n * 2048 + k * 1024); } while (0)
#define PG8_MMA(ai, bj, At, Bt) do { __builtin_amdgcn_s_setprio(1); _Pragma("unroll") for (int m = 0; m < 4; ++m) _Pragma("unroll") for (int n = 0; n < 2; ++n) _Pragma("unroll") for (int k = 0; k < 2; ++k) \
        acc[ai][bj][m][n] = __builtin_amdgcn_mfma_f32_16x16x32_bf16(Bt[n][k], At[m][k], acc[ai][bj][m][n], 0, 0, 0); __builtin_amdgcn_s_setprio(0); } while (0)
#define PG8_WAIT_V(n) asm volatile("s_waitcnt vmcnt(" #n ")" ::: "memory")
#define PG8_WAIT_L(n) asm volatile("s_waitcnt lgkmcnt(" #n ")" ::: "memory")
#define PG8_BAR __builtin_amdgcn_s_barrier()
#define PG8_SCHED __builtin_amdgcn_sched_barrier(0)
    Unit cur, nxt; int ui = 0;
    if (!S.next(0, cur)) return;
    f32x4 acc[2][2][4][2];
#pragma unroll
    for (int a = 0; a < 2; ++a)
#pragma unroll
        for (int b = 0; b < 2; ++b)
#pragma unroll
            for (int m = 0; m < 4; ++m)
#pragma unroll
                for (int n = 0; n < 2; ++n) acc[a][b][m][n] = (f32x4){0.f, 0.f, 0.f, 0.f};
    bf16x8 At[4][2], B0[2][2], B1[2][2];
    const char* cA = (const char*)g.A + (size_t)cur.pm * tstep; const char* cB = (const char*)g.Bt + (size_t)cur.pn * tstep;
    S.a_ready(cur);
    if constexpr (SP2) {
        PG8_STAGE(PG8_SB(0, 0), cB, voffB); PG8_STAGE(PG8_SB(0, 1), cB + hstep, voffB); PG8_STAGE(PG8_SA(0, 0), cA, voffA); PG8_STAGE(PG8_SA(0, 1), cA + hstep, voffA);
        if (wr == 1) PG8_BAR;
        PG8_WAIT_V(2); PG8_BAR;
        PG8_STAGE(PG8_SB(1, 0), cB + kstep, voffB); PG8_STAGE(PG8_SA(1, 0), cA + kstep, voffA); PG8_STAGE(PG8_SB(1, 1), cB + hstep + kstep, voffB);
        PG8_WAIT_V(6); PG8_BAR;
    } else {
        PG8_STAGE(PG8_SB(0, 0), cB, voffB); PG8_STAGE(PG8_SA(0, 0), cA, voffA); PG8_STAGE(PG8_SB(0, 1), cB + hstep, voffB); PG8_STAGE(PG8_SA(0, 1), cA + hstep, voffA);
        if (wr == 1) PG8_BAR;
        PG8_WAIT_V(4); PG8_BAR;
        PG8_STAGE(PG8_SB(1, 0), cB + kstep, voffB); PG8_STAGE(PG8_SA(1, 0), cA + kstep, voffA); PG8_STAGE(PG8_SB(1, 1), cB + hstep + kstep, voffB);
        PG8_WAIT_V(6); PG8_BAR;
    }
    for (;;) {
        const bool has_next = S.next(ui + 1, nxt);
        const char* nA = has_next ? (const char*)g.A + (size_t)nxt.pm * tstep : cA; const char* nB = has_next ? (const char*)g.Bt + (size_t)nxt.pn * tstep : cB;
        for (int t = 0; t < nt; t += 2) {
            const bool last = (t == nt - 2);
            const char* a1 = cA + (size_t)(t + 1) * kstep;
            const char* a2 = last ? nA : cA + (size_t)(t + 2) * kstep; const char* b2 = last ? nB : cB + (size_t)(t + 2) * kstep;
            const char* a3 = a2 + kstep; const char* b3 = b2 + kstep;
            if (last && has_next) S.a_ready(nxt);
            if constexpr (SP2) {
            PG8_LDB(B0, 0, 0); PG8_LDB(B1, 0, 1); PG8_SCHED; PG8_LDA(At, 0, 0); PG8_STAGE(PG8_SA(1, 1), a1 + hstep, voffA);
            PG8_WAIT_V(8); PG8_WAIT_L(0); PG8_BAR; PG8_MMA(0, 0, At, B0); PG8_MMA(0, 1, At, B1); PG8_BAR; PG8_SCHED;
            PG8_LDA(At, 0, 1); PG8_STAGE(PG8_SB(0, 0), b2, voffB); PG8_STAGE(PG8_SB(0, 1), b2 + hstep, voffB); PG8_STAGE(PG8_SA(0, 0), a2, voffA);
            PG8_WAIT_V(8); PG8_WAIT_L(0); PG8_BAR; PG8_MMA(1, 0, At, B0); PG8_MMA(1, 1, At, B1); PG8_BAR; PG8_SCHED;
            PG8_LDB(B0, 1, 0); PG8_LDB(B1, 1, 1); PG8_SCHED; PG8_LDA(At, 1, 0); PG8_STAGE(PG8_SA(0, 1), a2 + hstep, voffA);
            PG8_WAIT_V(8); PG8_WAIT_L(0); PG8_BAR; PG8_MMA(0, 0, At, B0); PG8_MMA(0, 1, At, B1); PG8_BAR; PG8_SCHED;
            PG8_LDA(At, 1, 1); PG8_STAGE(PG8_SB(1, 0), b3, voffB); PG8_STAGE(PG8_SB(1, 1), b3 + hstep, voffB); PG8_STAGE(PG8_SA(1, 0), a3, voffA);
            PG8_WAIT_V(8); PG8_WAIT_L(0); PG8_BAR; PG8_MMA(1, 0, At, B0); PG8_MMA(1, 1, At, B1); PG8_BAR; PG8_SCHED;
            } else {
            PG8_LDB(B0, 0, 0); PG8_SCHED; PG8_LDA(At, 0, 0); PG8_STAGE(PG8_SA(1, 1), a1 + hstep, voffA);
            PG8_WAIT_L(8); PG8_BAR; PG8_WAIT_L(0); PG8_MMA(0, 0, At, B0); PG8_BAR; PG8_SCHED;
            PG8_LDB(B1, 0, 1); PG8_STAGE(PG8_SB(0, 0), b2, voffB);
            PG8_BAR; PG8_WAIT_L(0); PG8_MMA(0, 1, At, B1); PG8_BAR;
            PG8_LDA(At, 0, 1); PG8_STAGE(PG8_SA(0, 0), a2, voffA);
            PG8_BAR; PG8_WAIT_L(0); PG8_MMA(1, 0, At, B0); PG8_BAR; PG8_SCHED;
            PG8_STAGE(PG8_SB(0, 1), b2 + hstep, voffB);
            PG8_WAIT_V(6); PG8_BAR; PG8_MMA(1, 1, At, B1); PG8_BAR;
            PG8_LDB(B0, 1, 0); PG8_SCHED; PG8_LDA(At, 1, 0); PG8_STAGE(PG8_SA(0, 1), a2 + hstep, voffA);
            PG8_WAIT_L(8); PG8_BAR; PG8_WAIT_L(0); PG8_MMA(0, 0, At, B0); PG8_BAR; PG8_SCHED;
            PG8_LDB(B1, 1, 1); PG8_STAGE(PG8_SB(1, 0), b3, voffB);
            PG8_BAR; PG8_WAIT_L(0); PG8_MMA(0, 1, At, B1); PG8_BAR;
            PG8_LDA(At, 1, 1); PG8_STAGE(PG8_SA(1, 0), a3, voffA);
            PG8_BAR; PG8_WAIT_L(0); PG8_MMA(1, 0, At, B0); PG8_BAR; PG8_SCHED;
            PG8_STAGE(PG8_SB(1, 1), b3 + hstep, voffB);
            PG8_WAIT_V(6); PG8_BAR; PG8_MMA(1, 1, At, B1); PG8_BAR;
            }
        }
        if constexpr (ALIGN_EPI) { if (wr == 0) PG8_BAR; }
        if constexpr (!Epi::AFTER_DRAIN) { int l_; asm volatile("v_mbcnt_lo_u32_b32 %0, -1, 0\n\tv_mbcnt_hi_u32_b32 %0, -1, %0" : "=v"(l_)); E(acc, cur, wr, wc, l_ & 15, l_ >> 4); S.done(cur); }
        if (!has_next) break;
        bool keep_ = false; if constexpr (Epi::CHAIN) keep_ = E.keep(cur);
        if (!keep_) {
#pragma unroll
        for (int a = 0; a < 2; ++a)
#pragma unroll
            for (int b = 0; b < 2; ++b)
#pragma unroll
                for (int m = 0; m < 4; ++m)
#pragma unroll
                    for (int n = 0; n < 2; ++n) acc[a][b][m][n] = (f32x4){0.f, 0.f, 0.f, 0.f};
        }
        cur = nxt; cA = nA; cB = nB; ++ui;
        if constexpr (ALIGN_EPI) { if (wr == 1) PG8_BAR; }
    }
    PG8_WAIT_V(0);
    if constexpr (!ALIGN_EPI) { if (wr == 0) PG8_BAR; }
    PG8_BAR;
    if constexpr (Epi::AFTER_DRAIN) { E.fused(acc, cur, wr, wc, fr, fq, lds, wid, lane); S.done(cur); }
#undef PG8_SA
#undef PG8_SB
#undef PG8_STAGE
#undef PG8_LDA
#undef PG8_LDB
#undef PG8_MMA
#undef PG8_WAIT_V
#undef PG8_WAIT_L
#undef PG8_BAR
#undef PG8_SCHED
}
}

constexpr int NWAVES = 8;
#ifndef MK_ONE_LAUNCH
#define MK_ONE_LAUNCH 1
#endif
#ifndef REP_G
#define REP_G 1
#endif
#ifndef REP_A
#define REP_A 1
#endif
#ifndef REP_M
#define REP_M 1
#endif
#ifndef REP_I
#define REP_I 1
#endif
#ifndef REP_P3
#define REP_P3 1
#endif
#ifndef REP_N
#define REP_N 1
#endif
#ifndef REP_MG
#define REP_MG 1
#endif
#ifndef REP_PRO
#define REP_PRO 1
#endif
constexpr int NB = 8, SEQ = 4096, D = 1024, M = NB * SEQ, NLAYER = 2;
constexpr int INW = 7240, NA = 17 * 256, NG = 3072, NIN = NA + NG, FF = 4096, PLE = 256;
constexpr float EPS = 1e-6f;
constexpr int PH_PER_LAYER = 13, NPH = 1 + NLAYER * PH_PER_LAYER;
constexpr size_t MiB = 1u << 20;
constexpr size_t WS_CTL = 0, CTL_ZERO_BYTES = 1 * MiB;
constexpr size_t WS_ROPE = 1 * MiB;
constexpr size_t WS_AGG = 3 * MiB;
constexpr size_t WS_W = 4 * MiB, W_LAYER = 38 * MiB;
constexpr size_t WO_IN = 0, WO_BR = WO_IN + (size_t)NIN * D * 2, WO_OUT = WO_BR + 3 * MiB, WO_UP = WO_OUT + 2 * MiB, WO_DN = WO_UP + 8 * MiB, WO_PLE = WO_DN + 8 * MiB, WO_PG = WO_PLE + MiB / 2;
static_assert(WO_PG + 2 * MiB == W_LAYER, "weight map");
constexpr size_t WS_P = 80 * MiB;
constexpr size_t WS_H = 112 * MiB;
constexpr size_t WS_Q = 176 * MiB, WS_K = 208 * MiB, WS_V = 240 * MiB, WS_XR = 272 * MiB, WS_GR = 304 * MiB, WS_ZV = 336 * MiB;
constexpr size_t WS_G = 176 * MiB;
constexpr size_t WS_QI = 368 * MiB, WS_ZU = 400 * MiB, WS_YC = 432 * MiB;
constexpr size_t WS_KI = 464 * MiB, WS_WI = 468 * MiB, WS_SEL = 469 * MiB;
constexpr size_t WS_T = 176 * MiB;
constexpr size_t WS_U = 176 * MiB;
constexpr size_t WS_T2 = 432 * MiB;
constexpr size_t WS_S = 176 * MiB, WS_T3 = 240 * MiB;
constexpr size_t WS_XPARK = 304 * MiB;
constexpr size_t WS_END = 496 * MiB;
constexpr int CW_BAR = 4096;
constexpr int LDS_BYTES = 155648;
constexpr int MISC_OFF = 147456 + 320;

#define GAS __attribute__((address_space(1)))
#define LAS __attribute__((address_space(3)))
typedef unsigned short bf16;
typedef unsigned v4u __attribute__((ext_vector_type(4)));
typedef unsigned v2u __attribute__((ext_vector_type(2)));
typedef float f32x4 __attribute__((ext_vector_type(4)));
typedef float f32x2 __attribute__((ext_vector_type(2)));
typedef GAS unsigned gu32;
#define RLX_AGENT __ATOMIC_RELAXED, __HIP_MEMORY_SCOPE_AGENT
#define LDS_WAIT() asm volatile("s_waitcnt lgkmcnt(0)" ::: "memory")
#define VM_WAIT() asm volatile("s_waitcnt vmcnt(0)" ::: "memory")
using pg8::bflo; using pg8::bfhi; using pg8::unpack8; using pg8::pack8; using pg8::sigm;
__device__ __forceinline__ float bf2f(bf16 b) { return __builtin_bit_cast(float, (unsigned)b << 16); }
__device__ __forceinline__ unsigned f2bf(float f) { unsigned u = __builtin_bit_cast(unsigned, f); return (u + 0x7fffu + ((u >> 16) & 1u)) >> 16; }
__device__ __forceinline__ unsigned pk2(float lo, float hi) { return f2bf(lo) | (f2bf(hi) << 16); }

__device__ __forceinline__ int lane_id() { int l; asm volatile("v_mbcnt_lo_u32_b32 %0, -1, 0\n\tv_mbcnt_hi_u32_b32 %0, -1, %0" : "=v"(l)); return l; }
#define XB_TMO      128
#define XB_XCNT(j)  (256  + 64 * (j))
#define XB_XSUB(j)  (1280 + 64 * (j))
#define XB_XGEN(j)  (2304 + 64 * (j))
#define XB_TOP      3328
#define XB_TOPGEN   3392
#define XCD_BAR_WORDS 3456
#define XB_SPIN_CAP (1u << 18)

__device__ __forceinline__ unsigned xb_ld(unsigned* p)              { return __hip_atomic_load(p, __ATOMIC_RELAXED, __HIP_MEMORY_SCOPE_AGENT); }
__device__ __forceinline__ unsigned xb_add(unsigned* p, unsigned v) { return __hip_atomic_fetch_add(p, v, __ATOMIC_RELAXED, __HIP_MEMORY_SCOPE_AGENT); }
__device__ __forceinline__ unsigned xb_xcc_id() { return (unsigned)__builtin_amdgcn_s_getreg((3 << 11) | 20) & 0xFu; }
#define XB_SPIN(cond, bar) do { unsigned _sp = 0; while (cond) { __builtin_amdgcn_s_sleep(1); \
    if ((++_sp & 255u) == 0u) { if (xb_ld(&(bar)[XB_TMO])) break; if (_sp > XB_SPIN_CAP) { atomicAdd(&(bar)[XB_TMO], 1u); break; } } } } while (0)

struct XcdBarrier {
    unsigned* bar; unsigned x;
    volatile LAS unsigned* st;
    int w0;
};

__device__ __forceinline__ XcdBarrier xcd_barrier_post(unsigned* bar, volatile LAS unsigned* st, int w0) {
    XcdBarrier b; b.bar = bar; b.x = xb_xcc_id(); b.st = st; b.w0 = w0;
    if (w0 == 0 && lane_id() == 0) (void)xb_add(&bar[XB_XCNT(b.x)], 1u);
    return b;
}
__device__ __forceinline__ void xcd_barrier_complete(unsigned* bar, unsigned x, unsigned& nloc, unsigned& nx) {
    const unsigned G = gridDim.x * gridDim.y * gridDim.z;
    unsigned sum, cnt, mine, sp = 0u;
    for (;;) {
        sum = 0u; cnt = 0u; mine = 0u;
#pragma unroll
        for (unsigned j = 0; j < 16; ++j) { const unsigned c = xb_ld(&bar[XB_XCNT(j)]); sum += c; cnt += (c > 0u) ? 1u : 0u; mine = (j == x) ? c : mine; }
        if (sum == G) break;
        __builtin_amdgcn_s_sleep(1);
        if ((++sp & 255u) == 0u) { if (xb_ld(&bar[XB_TMO])) break; if (sp > XB_SPIN_CAP) { atomicAdd(&bar[XB_TMO], 1u); break; } }
    }
    nloc = mine > 0u ? mine : 1u; nx = cnt > 0u ? cnt : 1u;
}

__device__ __forceinline__ void xcd_barrier(const XcdBarrier& b) {
    asm volatile("s_waitcnt vmcnt(0)" ::: "memory");
    __syncthreads();
    if (b.w0 == 0 && lane_id() == 0) {
        unsigned* bar = b.bar;
        __builtin_amdgcn_s_waitcnt(0);
        unsigned nloc = b.st[0], nx = b.st[1];
        if (nloc == 0u) { xcd_barrier_complete(bar, b.x, nloc, nx); b.st[0] = nloc; b.st[1] = nx; }
        const unsigned old = xb_add(&bar[XB_XSUB(b.x)], 1u);
        const unsigned gen = old / nloc;
        if (old + 1u == (gen + 1u) * nloc) {
            __builtin_amdgcn_fence(__ATOMIC_RELEASE, "agent");
            asm volatile("s_waitcnt vmcnt(0)" ::: "memory");
            const unsigned og = xb_add(&bar[XB_TOP], 1u);
            const unsigned tg = og / nx;
            if (og + 1u == (tg + 1u) * nx) xb_add(&bar[XB_TOPGEN], 1u);
            else XB_SPIN(xb_ld(&bar[XB_TOPGEN]) == tg, bar);
            __builtin_amdgcn_fence(__ATOMIC_ACQUIRE, "agent");
            xb_add(&bar[XB_XGEN(b.x)], 1u);
            asm volatile("s_waitcnt vmcnt(0)" ::: "memory");
        } else {
            XB_SPIN(xb_ld(&bar[XB_XGEN(b.x)]) == gen, bar);
            __builtin_amdgcn_fence(__ATOMIC_ACQUIRE, "agent");
            asm volatile("s_waitcnt vmcnt(0)" ::: "memory");
        }
    }
    __syncthreads();
}


__device__ __forceinline__ float wave_sum(float v) {
#pragma unroll
    for (int o = 1; o < 64; o <<= 1) v += __shfl_xor(v, o);
    return v;
}
__device__ __forceinline__ float wave_max(float v) {
#pragma unroll
    for (int o = 1; o < 64; o <<= 1) v = fmaxf(v, __shfl_xor(v, o));
    return v;
}
__device__ __forceinline__ int prefix_popc(unsigned long long m) { return (int)__builtin_amdgcn_mbcnt_hi((unsigned)(m >> 32), __builtin_amdgcn_mbcnt_lo((unsigned)m, 0u)); }

__device__ __forceinline__ void zero_rows(bf16* Y, int blk, int G, int tid) { for (size_t e = (size_t)(blk * 512 + tid) * 8; e < (size_t)M * 512; e += (size_t)G * 512 * 8) *(GAS v4u*)(Y + e) = (v4u){0u, 0u, 0u, 0u}; }
template <class Map>
__device__ __forceinline__ void transpose_item(const float* W, int K, int Nsrc, bf16* WT, int nblk, LAS float* scr, int item, int lane, Map map) {
    const int kb = item / nblk, nb = item % nblk, k0 = 64 * kb, d0 = 32 * nb;
    const int sb = map.base(d0), cnt = map.count(d0); const bool il = map.interleave(d0);
    const int c4 = (lane & 7) * 4, kr = lane >> 3;
    int dp[4];
#pragma unroll
    for (int e = 0; e < 4; ++e) { const int c = c4 + e; dp[e] = (il && c < 16) ? 2 * (c & 7) + (c >> 3) : c; }
#pragma unroll
    for (int i = 0; i < 8; ++i) { const int kk = 8 * i + kr;
        const f32x4 v = c4 < cnt ? *(const GAS f32x4*)(W + (size_t)(k0 + kk) * Nsrc + sb + c4) : (f32x4){0.f, 0.f, 0.f, 0.f};
        scr[kk * 33 + dp[0]] = v[0]; scr[kk * 33 + dp[1]] = v[1]; scr[kk * 33 + dp[2]] = v[2]; scr[kk * 33 + dp[3]] = v[3]; }
    LDS_WAIT();
    const int c = lane & 7;
#pragma unroll
    for (int j = 0; j < 4; ++j) { const int n = (lane >> 3) + 8 * j; const LAS float* s = scr + (8 * c) * 33 + n;
        v4u o; o.x = pk2(s[0 * 33], s[1 * 33]); o.y = pk2(s[2 * 33], s[3 * 33]); o.z = pk2(s[4 * 33], s[5 * 33]); o.w = pk2(s[6 * 33], s[7 * 33]);
        *(GAS v4u*)(WT + (size_t)(d0 + n) * K + k0 + 8 * c) = o; }
    LDS_WAIT();
}
struct MapIdent { int off; __device__ __forceinline__ int base(int d0) const { return off + d0; } __device__ __forceinline__ int count(int) const { return 32; } __device__ __forceinline__ bool interleave(int) const { return false; } };
struct MapIn {
    __device__ __forceinline__ int base(int d0) const {
        const int tile = d0 >> 8, r = d0 & 255;
        if (tile < 16) { const int seg = tile >> 1;
            const int sbs = seg == 0 ? 0 : seg == 1 ? 512 : seg == 2 ? 1024 : seg == 3 ? 1536 : seg == 4 ? 2120 : seg == 5 ? 2632 : seg == 6 ? 3144 : 3656;
            return sbs + (tile & 1) * 256 + r; }
        if (tile == 16) return r < 64 ? 2048 + r : 2112;
        return 4168 + (d0 - NA);
    }
    __device__ __forceinline__ int count(int d0) const { const int tile = d0 >> 8, r = d0 & 255; return tile != 16 ? 32 : r < 64 ? 32 : r == 64 ? 8 : 0; }
    __device__ __forceinline__ bool interleave(int d0) const { const int tile = d0 >> 8, r = d0 & 255, seg = tile >> 1;
        return ((tile < 16 && (seg == 0 || seg == 1 || seg == 3)) || tile == 16) && (r & 63) == 0 && (tile != 16 || r == 0); }
};
__device__ __forceinline__ void sincos_d(float af, float& s, float& c) {
    const double a = (double)af;
    const double k = __builtin_rint(a * 0.63661977236758134308);
    double r = __builtin_fma(-k, 1.57079632679489655800e+00, a); r = __builtin_fma(-k, 6.12323399573676603587e-17, r);
    const double r2 = r * r;
    double sp = -7.6471637318198164759e-13; sp = sp * r2 + 1.6059043836821614599e-10; sp = sp * r2 - 2.5052108385441718775e-08; sp = sp * r2 + 2.7557319223985890653e-06; sp = sp * r2 - 1.9841269841269841270e-04; sp = sp * r2 + 8.3333333333333333333e-03; sp = sp * r2 - 1.6666666666666666667e-01;
    const double sn = r + r * r2 * sp;
    double cp = 4.7794773323873852974e-14; cp = cp * r2 - 1.1470745597729724714e-11; cp = cp * r2 + 2.0876756987868098979e-09; cp = cp * r2 - 2.7557319223985890653e-07; cp = cp * r2 + 2.4801587301587301587e-05; cp = cp * r2 - 1.3888888888888888889e-03; cp = cp * r2 + 4.1666666666666666667e-02; cp = cp * r2 - 0.5;
    const double cn = 1.0 + r2 * cp;
    const int q = (int)((long long)k & 3);
    const double ss = (q == 0) ? sn : (q == 1) ? cn : (q == 2) ? -sn : -cn;
    const double cc = (q == 0) ? cn : (q == 1) ? -sn : (q == 2) ? -cn : sn;
    s = (float)ss; c = (float)cc;
}

struct Args { const float* in[25]; float* out; unsigned char* ws; int ph_lo, ph_hi; };
typedef __attribute__((address_space(4))) const unsigned char* kptr_t;
__device__ __forceinline__ kptr_t kbase() { kptr_t k = (kptr_t)__builtin_amdgcn_kernarg_segment_ptr(); asm volatile("" : "+s"(k)); return k; }
__device__ __forceinline__ const float* kin(int i) { return *(const float* const __attribute__((address_space(4)))*)(kbase() + 8 * i); }
__device__ __forceinline__ float* kout() { return *(float* const __attribute__((address_space(4)))*)(kbase() + 200); }
__device__ __forceinline__ unsigned char* kws() { return *(unsigned char* const __attribute__((address_space(4)))*)(kbase() + 208); }
static_assert(sizeof(Args) == 224, "Args layout");

typedef _Float16 f16x4 __attribute__((ext_vector_type(4)));
template <class TI> __device__ __forceinline__ f32x4 ld_x4(const TI* p);
template <> __device__ __forceinline__ f32x4 ld_x4<float>(const float* p) { return *(const GAS f32x4*)p; }
template <> __device__ __forceinline__ f32x4 ld_x4<_Float16>(const _Float16* p) { const f16x4 h = *(const GAS f16x4*)p; return (f32x4){(float)h[0], (float)h[1], (float)h[2], (float)h[3]}; }
__device__ __forceinline__ void st_x4(float* p, f32x4 v) { *(GAS f32x4*)p = v; }
__device__ __forceinline__ void st_x4(_Float16* p, f32x4 v) { *(GAS f16x4*)p = (f16x4){(_Float16)v[0], (_Float16)v[1], (_Float16)v[2], (_Float16)v[3]}; }
template <class TI, class TO>
__device__ __forceinline__ void norm_phase(const TI* xin, TO* xout, const bf16* T, const float* gpost, const float* gnext, bf16* O, int mode, int gw, int NGW, int lane, float tscale = 1.f) {
    constexpr int R = 2;
    for (int row0 = gw; row0 < M; row0 += R * NGW) {
        f32x4 x[R][4], t[R][4];
#pragma unroll
        for (int rr = 0; rr < R; ++rr) { const size_t row = (size_t)(row0 + rr * NGW);
#pragma unroll
            for (int j = 0; j < 4; ++j) x[rr][j] = ld_x4<TI>(xin + row * D + j * 256 + lane * 4);
            if (T) {
#pragma unroll
                for (int j = 0; j < 4; ++j) { const v2u w = *(const GAS v2u*)(T + row * D + j * 256 + lane * 4); t[rr][j] = (f32x4){bflo(w.x), bfhi(w.x), bflo(w.y), bfhi(w.y)}; } }
        }
#pragma unroll
        for (int rr = 0; rr < R; ++rr) { const size_t row = (size_t)(row0 + rr * NGW);
            if (T) {
                float ss = 0.f;
#pragma unroll
                for (int j = 0; j < 4; ++j) ss += (t[rr][j][0] * t[rr][j][0] + t[rr][j][1] * t[rr][j][1]) + (t[rr][j][2] * t[rr][j][2] + t[rr][j][3] * t[rr][j][3]);
                const float r = 1.f / sqrtf(wave_sum(ss) * (1.f / D) + EPS);
#pragma unroll
                for (int j = 0; j < 4; ++j) { const f32x4 g = *(const GAS f32x4*)(gpost + j * 256 + lane * 4); x[rr][j] += t[rr][j] * (r * tscale) * g; }
            }
            if (xout) {
#pragma unroll
                for (int j = 0; j < 4; ++j) st_x4(xout + row * D + j * 256 + lane * 4, x[rr][j]); }
            if (mode == 0) {
                float ss = 0.f;
#pragma unroll
                for (int j = 0; j < 4; ++j) ss += (x[rr][j][0] * x[rr][j][0] + x[rr][j][1] * x[rr][j][1]) + (x[rr][j][2] * x[rr][j][2] + x[rr][j][3] * x[rr][j][3]);
                const float r = 1.f / sqrtf(wave_sum(ss) * (1.f / D) + EPS);
#pragma unroll
                for (int j = 0; j < 4; ++j) { const f32x4 g = *(const GAS f32x4*)(gnext + j * 256 + lane * 4); const f32x4 o = x[rr][j] * r * g;
                    *(GAS v2u*)(O + row * D + j * 256 + lane * 4) = (v2u){pg8::cvt_pk_bf16(o[0], o[1]), pg8::cvt_pk_bf16(o[2], o[3])}; }
            } else if (mode == 1) {
#pragma unroll
                for (int j = 0; j < 4; ++j) *(GAS v2u*)(O + row * D + j * 256 + lane * 4) = (v2u){pg8::cvt_pk_bf16(x[rr][j][0], x[rr][j][1]), pg8::cvt_pk_bf16(x[rr][j][2], x[rr][j][3])};
            }
        }
    }
}

typedef float f32x16 __attribute__((ext_vector_type(16)));
typedef short bf16x8v __attribute__((ext_vector_type(8)));
#define MFMA32(a, b, c) __builtin_amdgcn_mfma_f32_32x32x16_bf16((a), (b), (c), 0, 0, 0)
__device__ __forceinline__ bf16x8v pack_frag(float a0, float a1, float a2, float a3, float a4, float a5, float a6, float a7) {
    v4u w; w.x = pg8::cvt_pk_bf16(a0, a1); w.y = pg8::cvt_pk_bf16(a2, a3); w.z = pg8::cvt_pk_bf16(a4, a5); w.w = pg8::cvt_pk_bf16(a6, a7); return __builtin_bit_cast(bf16x8v, w); }
__device__ __forceinline__ float and_bits(float x, int m) { return __builtin_bit_cast(float, __builtin_bit_cast(int, x) & m); }
constexpr int AT_P = 144, AT_BUF = 64 * AT_P, AT_VOFF = 2 * AT_BUF;
template <bool SAFE>
__device__ __forceinline__ bool attn_unit(LAS unsigned char* lds, const bf16* Q, const bf16* K, const bf16* V, const unsigned* MASK, bf16* YA, int b, int h, int qb, int tid, int wave, int lane) {
    const int r = lane & 31, hi = lane >> 5;
    const int skey = tid >> 3, sch = tid & 7;
    const int spos = (skey & 0x33) | ((skey & 4) << 1) | ((skey & 8) >> 1);
    LAS unsigned char* kw = lds + skey * AT_P + sch * 16;
    LAS unsigned char* vw = lds + AT_VOFF + (sch * 8) * AT_P + spos * 2;
    LAS unsigned* flag = (LAS unsigned*)(lds + AT_VOFF + 2 * AT_BUF);
    const int ntile = 4 * (qb + 1);
    const size_t rowbase = (size_t)b * SEQ;
    const int q = qb * 256 + wave * 32 + r;
    bf16x8v qf[4];
#pragma unroll
    for (int ks = 0; ks < 4; ++ks) qf[ks] = *(const GAS bf16x8v*)(Q + (rowbase + q) * 512 + h * 64 + 16 * ks + 8 * hi);
    const GAS unsigned* mrow = (const GAS unsigned*)MASK + (rowbase + q) * 128;
    const bf16* kg = K + (rowbase + skey) * 512 + h * 64 + sch * 8;
    const bf16* vg = V + (rowbase + skey) * 512 + h * 64 + sch * 8;
    float m = SAFE ? -1e30f : 0.f;
    f32x16 o0, o1, o2;
#pragma unroll
    for (int i = 0; i < 16; ++i) { o0[i] = 0.f; o1[i] = 0.f; o2[i] = 0.f; }
    const unsigned one2 = r == 0 ? 0x3F803F80u : 0u;
    const bf16x8v onesf = __builtin_bit_cast(bf16x8v, (v4u){one2, one2, one2, one2});
    v4u kreg = *(const GAS v4u*)kg, vreg = *(const GAS v4u*)vg;
    v2u mw = *(const GAS v2u*)mrow;
    __syncthreads();
    if (tid == 0) flag[0] = 0u;
    *(LAS v4u*)kw = kreg;
    { const unsigned vv[4] = {vreg.x, vreg.y, vreg.z, vreg.w};
#pragma unroll
      for (int i = 0; i < 8; ++i) *(LAS unsigned short*)(vw + i * AT_P) = (unsigned short)(vv[i >> 1] >> (16 * (i & 1))); }
    __syncthreads();
#pragma unroll 1
    for (int it = 0; it < ntile; ++it) {
        const int cur = it & 1; const bool more = it + 1 < ntile;
        v4u kn = kreg, vn = vreg; v2u mwn = mw;
        if (more) { kn = *(const GAS v4u*)(kg + (size_t)(it + 1) * 64 * 512); vn = *(const GAS v4u*)(vg + (size_t)(it + 1) * 64 * 512); mwn = *(const GAS v2u*)(mrow + (it + 1) * 2); }
        const LAS unsigned char* kb = lds + cur * AT_BUF;
        const LAS unsigned char* vb = lds + AT_VOFF + cur * AT_BUF;
        f32x16 s0, s1;
#pragma unroll
        for (int i = 0; i < 16; ++i) { s0[i] = 0.f; s1[i] = 0.f; }
#pragma unroll
        for (int ks = 0; ks < 4; ++ks) {
            const bf16x8v a0 = *(const LAS bf16x8v*)(kb + r * AT_P + (16 * ks + 8 * hi) * 2), a1 = *(const LAS bf16x8v*)(kb + (32 + r) * AT_P + (16 * ks + 8 * hi) * 2);
            s0 = MFMA32(a0, qf[ks], s0); s1 = MFMA32(a1, qf[ks], s1); }
        const int w0 = (int)(mw.x >> (4 * hi)), w1 = (int)(mw.y >> (4 * hi));
        float mn = 0.f;
        if (SAFE) {
            float mx = fmaxf(s0[0], s1[0]);
#pragma unroll
            for (int i = 1; i < 16; ++i) mx = fmaxf(mx, fmaxf(s0[i], s1[i]));
            mx = fmaxf(mx, __shfl_xor(mx, 32));
            mn = fmaxf(m, mx);
            if (__any(mn != m)) {
                const float alpha = __builtin_amdgcn_exp2f(m - mn); m = mn;
#pragma unroll
                for (int i = 0; i < 16; ++i) { o0[i] *= alpha; o1[i] *= alpha; }
                o2[0] *= alpha;
            }
        }
#pragma unroll
        for (int i = 0; i < 16; ++i) { const int p = 8 * (i >> 2) + (i & 3);
            s0[i] = and_bits(__builtin_amdgcn_exp2f(SAFE ? s0[i] - mn : s0[i]), __builtin_amdgcn_sbfe(w0, p, 1)); s1[i] = and_bits(__builtin_amdgcn_exp2f(SAFE ? s1[i] - mn : s1[i]), __builtin_amdgcn_sbfe(w1, p, 1)); }
        const bf16x8v p00 = pack_frag(s0[0], s0[1], s0[2], s0[3], s0[4], s0[5], s0[6], s0[7]), p01 = pack_frag(s0[8], s0[9], s0[10], s0[11], s0[12], s0[13], s0[14], s0[15]);
        const bf16x8v p10 = pack_frag(s1[0], s1[1], s1[2], s1[3], s1[4], s1[5], s1[6], s1[7]), p11 = pack_frag(s1[8], s1[9], s1[10], s1[11], s1[12], s1[13], s1[14], s1[15]);
        o2 = MFMA32(onesf, p00, o2); o2 = MFMA32(onesf, p01, o2); o2 = MFMA32(onesf, p10, o2); o2 = MFMA32(onesf, p11, o2);
#define AT_VF(dt, st, s) (*(const LAS bf16x8v*)(vb + (32 * (dt) + r) * AT_P + ((((st) << 5) | ((s) << 4)) + 8 * hi) * 2))
        o0 = MFMA32(AT_VF(0, 0, 0), p00, o0); o0 = MFMA32(AT_VF(0, 0, 1), p01, o0); o0 = MFMA32(AT_VF(0, 1, 0), p10, o0); o0 = MFMA32(AT_VF(0, 1, 1), p11, o0);
        o1 = MFMA32(AT_VF(1, 0, 0), p00, o1); o1 = MFMA32(AT_VF(1, 0, 1), p01, o1); o1 = MFMA32(AT_VF(1, 1, 0), p10, o1); o1 = MFMA32(AT_VF(1, 1, 1), p11, o1);
#undef AT_VF
        if (more) {
            *(LAS v4u*)(kw + (cur ^ 1) * AT_BUF) = kn;
            const unsigned vv[4] = {vn.x, vn.y, vn.z, vn.w};
#pragma unroll
            for (int i = 0; i < 8; ++i) *(LAS unsigned short*)(vw + (cur ^ 1) * AT_BUF + i * AT_P) = (unsigned short)(vv[i >> 1] >> (16 * (i & 1)));
            mw = mwn;
        }
        __syncthreads();
    }
    const float l = __shfl(o2[0], r);
    const bool okl = l > 1e-30f && l < 1e30f;
    if (!SAFE) { if (__any(!okl) && lane == 0) flag[0] = 1u; }
    const float inv = okl ? 1.f / l : 0.f;
    bf16* yo = YA + (rowbase + q) * 512 + h * 64 + 4 * hi;
#pragma unroll
    for (int g = 0; g < 4; ++g) {
        *(GAS v2u*)(yo + 8 * g) = (v2u){pg8::cvt_pk_bf16(o0[4 * g] * inv, o0[4 * g + 1] * inv), pg8::cvt_pk_bf16(o0[4 * g + 2] * inv, o0[4 * g + 3] * inv)};
        *(GAS v2u*)(yo + 32 + 8 * g) = (v2u){pg8::cvt_pk_bf16(o1[4 * g] * inv, o1[4 * g + 1] * inv), pg8::cvt_pk_bf16(o1[4 * g + 2] * inv, o1[4 * g + 3] * inv)};
    }
    if (SAFE) return true;
    __syncthreads();
    return flag[0] == 0u;
}
__device__ __forceinline__ bool attn_unit_fast(LAS unsigned char* lds, const bf16* Q, const bf16* K, const bf16* V, const unsigned* MASK, bf16* YA, int b, int h, int qb, int tid_, int wave, int lane_) {
    int tid = tid_, lane = lane_; asm volatile("" : "+v"(tid), "+v"(lane));
    const int r = lane & 31, hi = lane >> 5;
    const int skey = tid >> 3, sch = tid & 7;
    const int spos = (skey & 0x33) | ((skey & 4) << 1) | ((skey & 8) >> 1);
    LAS unsigned char* kw = lds + skey * AT_P + sch * 16;
    LAS unsigned char* vw = lds + AT_VOFF + (sch * 8) * AT_P + spos * 2;
    const LAS unsigned char* krd = lds + r * AT_P + 16 * hi;
    const LAS unsigned char* vrd = lds + AT_VOFF + r * AT_P + 16 * hi;
    LAS unsigned* flag = (LAS unsigned*)(lds + AT_VOFF + 2 * AT_BUF);
    const int ntile = 4 * (qb + 1);
    const size_t rowbase = (size_t)b * SEQ;
    const int q = qb * 256 + wave * 32 + r;
    bf16x8v qf[4];
#pragma unroll
    for (int ks = 0; ks < 4; ++ks) qf[ks] = *(const GAS bf16x8v*)(Q + (rowbase + q) * 512 + h * 64 + 16 * ks + 8 * hi);
    const GAS unsigned* mrow = (const GAS unsigned*)MASK + (rowbase + q) * 128;
    const bf16* kg = K + (rowbase + skey) * 512 + h * 64 + sch * 8;
    const bf16* vg = V + (rowbase + skey) * 512 + h * 64 + sch * 8;
    float lsum = 0.f;
    f32x16 o0, o1, a0, a1, b0, b1;
#pragma unroll
    for (int i = 0; i < 16; ++i) { o0[i] = 0.f; o1[i] = 0.f; a0[i] = 0.f; a1[i] = 0.f; b0[i] = 0.f; b1[i] = 0.f; }
#define AF_SB() __builtin_amdgcn_sched_barrier(0)
#define AF_WRITE_V(slot_, reg_) do { const unsigned vv_[4] = {reg_.x, reg_.y, reg_.z, reg_.w}; _Pragma("unroll") for (int i_ = 0; i_ < 8; ++i_) \
        *(LAS unsigned short*)(vw + (slot_) * AT_BUF + i_ * AT_P) = (unsigned short)(vv_[i_ >> 1] >> (16 * (i_ & 1))); } while (0)
#define AF_EXPM(X, i_, w_) X[i_] = and_bits(__builtin_amdgcn_exp2f(X[i_]), __builtin_amdgcn_sbfe(w_, 8 * ((i_) >> 2) + ((i_) & 3), 1))
    { const v4u kreg = *(const GAS v4u*)kg, vreg = *(const GAS v4u*)vg, kreg1 = *(const GAS v4u*)(kg + (size_t)64 * 512);
      __syncthreads();
      if (tid == 0) flag[0] = 0u;
      *(LAS v4u*)kw = kreg; *(LAS v4u*)(kw + AT_BUF) = kreg1;
      AF_WRITE_V(0, vreg); }
    v2u mw = *(const GAS v2u*)mrow;
    __syncthreads();
    {
#pragma unroll
        for (int ks = 0; ks < 4; ++ks) { const bf16x8v k0 = *(const LAS bf16x8v*)(krd + 32 * ks), k1 = *(const LAS bf16x8v*)(krd + 32 * AT_P + 32 * ks);
            a0 = MFMA32(k0, qf[ks], a0); a1 = MFMA32(k1, qf[ks], a1); }
        const int w0 = (int)(mw.x >> (4 * hi)), w1 = (int)(mw.y >> (4 * hi));
#pragma unroll
        for (int i = 0; i < 16; ++i) { AF_EXPM(a0, i, w0); AF_EXPM(a1, i, w1); }
        mw = *(const GAS v2u*)(mrow + 2);
        LDS_WAIT(); __syncthreads();
    }
#define AF_PV_(P0, P1, v_) ((v_) < 16 ? P0[(v_) & 15] : P1[(v_) & 15])
#define AF_STEP(C0, C1, P0, P1, t_, KY, VY, MY, KX, VX, MX) do {     \
        const int cur = (t_) & 1, tk2 = (t_) + 2 < ntile ? (t_) + 2 : ntile - 1, tv1 = (t_) + 1 < ntile ? (t_) + 1 : ntile - 1; \
        KX = *(const GAS v4u*)(kg + (size_t)tk2 * 64 * 512); VX = *(const GAS v4u*)(vg + (size_t)tv1 * 64 * 512); \
        MX = *(const GAS v2u*)(mrow + tk2 * 2); \
        const LAS unsigned char* kb_ = krd + cur * AT_BUF; const LAS unsigned char* vb_ = vrd + (cur ^ 1) * AT_BUF; \
        bf16x8v kf[8], vf[8]; v4u pw[4]; \
        _Pragma("unroll") for (int k_ = 0; k_ < 2; ++k_) kf[k_] = *(const LAS bf16x8v*)(kb_ + (k_ & 1) * 32 * AT_P + 32 * (k_ >> 1));     \
        AF_SB(); \
        _Pragma("unroll") for (int k_ = 0; k_ < 8; ++k_) {     \
            if (k_ + 2 < 8) kf[k_ + 2] = *(const LAS bf16x8v*)(kb_ + ((k_ + 2) & 1) * 32 * AT_P + 32 * ((k_ + 2) >> 1)); \
            if ((k_ & 1) == 0) C0 = MFMA32(kf[k_], qf[k_ >> 1], C0); else C1 = MFMA32(kf[k_], qf[k_ >> 1], C1); \
            const float v0_ = AF_PV_(P0, P1, 4 * k_), v1_ = AF_PV_(P0, P1, 4 * k_ + 1), v2_ = AF_PV_(P0, P1, 4 * k_ + 2), v3_ = AF_PV_(P0, P1, 4 * k_ + 3); \
            lsum += (v0_ + v1_) + (v2_ + v3_); \
            if ((k_ & 1) == 0) { pw[k_ >> 1].x = pg8::cvt_pk_bf16(v0_, v1_); pw[k_ >> 1].y = pg8::cvt_pk_bf16(v2_, v3_); } else { pw[k_ >> 1].z = pg8::cvt_pk_bf16(v0_, v1_); pw[k_ >> 1].w = pg8::cvt_pk_bf16(v2_, v3_); } \
            if (k_ >= 6) vf[k_ - 6] = *(const LAS bf16x8v*)(vb_ + 32 * ((k_ - 6) & 1) * AT_P + (((((k_ - 6) >> 1) >> 1) << 5) | ((((k_ - 6) >> 1) & 1) << 4)) * 2); \
            AF_SB(); } \
        const int w0_ = (int)(mw.x >> (4 * hi)), w1_ = (int)(mw.y >> (4 * hi)); \
        _Pragma("unroll") for (int k_ = 0; k_ < 8; ++k_) {     \
            if (k_ + 2 < 8) vf[k_ + 2] = *(const LAS bf16x8v*)(vb_ + 32 * ((k_ + 2) & 1) * AT_P + (((((k_ + 2) >> 1) >> 1) << 5) | ((((k_ + 2) >> 1) & 1) << 4)) * 2); \
            if ((k_ & 1) == 0) o0 = MFMA32(vf[k_], __builtin_bit_cast(bf16x8v, pw[k_ >> 1]), o0); else o1 = MFMA32(vf[k_], __builtin_bit_cast(bf16x8v, pw[k_ >> 1]), o1); \
            if (k_ < 4) { AF_EXPM(C0, 4 * k_, w0_); AF_EXPM(C0, 4 * k_ + 1, w0_); AF_EXPM(C0, 4 * k_ + 2, w0_); AF_EXPM(C0, 4 * k_ + 3, w0_); } \
            else { AF_EXPM(C1, 4 * k_ - 16, w1_); AF_EXPM(C1, 4 * k_ - 15, w1_); AF_EXPM(C1, 4 * k_ - 14, w1_); AF_EXPM(C1, 4 * k_ - 13, w1_); } \
            AF_SB(); } \
        if ((t_) + 1 < ntile) *(LAS v4u*)(kw + (cur ^ 1) * AT_BUF) = KY; \
        AF_WRITE_V(cur, VY); mw = MY; \
        _Pragma("unroll") for (int i_ = 0; i_ < 16; ++i_) { P0[i_] = 0.f; P1[i_] = 0.f; }     \
        asm volatile("s_waitcnt lgkmcnt(0)\n\ts_barrier" ::: "memory");     \
        } while (0)
    v4u kn1 = *(const GAS v4u*)(kg + (size_t)2 * 64 * 512), vn1 = *(const GAS v4u*)(vg + (size_t)1 * 64 * 512), kn2 = kn1, vn2 = vn1;
    v2u mn1 = *(const GAS v2u*)(mrow + 4), mn2 = mn1;
    int t = 1;
#pragma unroll 1
    for (; t + 1 < ntile; t += 2) { AF_STEP(b0, b1, a0, a1, t, kn1, vn1, mn1, kn2, vn2, mn2); AF_STEP(a0, a1, b0, b1, t + 1, kn2, vn2, mn2, kn1, vn1, mn1); }
    AF_STEP(b0, b1, a0, a1, t, kn1, vn1, mn1, kn2, vn2, mn2);
    asm volatile("s_waitcnt vmcnt(0)" ::: "memory");
    { const LAS unsigned char* vb_ = vrd + ((ntile - 1) & 1) * AT_BUF;
      float s_ = 0.f;
#pragma unroll
      for (int i = 0; i < 16; ++i) s_ += b0[i] + b1[i];
      lsum += s_;
      const bf16x8v p00 = pack_frag(b0[0], b0[1], b0[2], b0[3], b0[4], b0[5], b0[6], b0[7]), p01 = pack_frag(b0[8], b0[9], b0[10], b0[11], b0[12], b0[13], b0[14], b0[15]);
      const bf16x8v p10 = pack_frag(b1[0], b1[1], b1[2], b1[3], b1[4], b1[5], b1[6], b1[7]), p11 = pack_frag(b1[8], b1[9], b1[10], b1[11], b1[12], b1[13], b1[14], b1[15]);
#define AF_VF(dt, st, s) (*(const LAS bf16x8v*)(vb_ + 32 * (dt) * AT_P + (((st) << 5) | ((s) << 4)) * 2))
      o0 = MFMA32(AF_VF(0, 0, 0), p00, o0); o1 = MFMA32(AF_VF(1, 0, 0), p00, o1); o0 = MFMA32(AF_VF(0, 0, 1), p01, o0); o1 = MFMA32(AF_VF(1, 0, 1), p01, o1);
      o0 = MFMA32(AF_VF(0, 1, 0), p10, o0); o1 = MFMA32(AF_VF(1, 1, 0), p10, o1); o0 = MFMA32(AF_VF(0, 1, 1), p11, o0); o1 = MFMA32(AF_VF(1, 1, 1), p11, o1);
#undef AF_VF
    }
#undef AF_SB
#undef AF_WRITE_V
#undef AF_EXPM
#undef AF_PV_
#undef AF_STEP
    const float l = lsum + __shfl_xor(lsum, 32);
    const bool okl = l > 1e-30f && l < 1e30f;
    if (__any(!okl) && lane == 0) flag[0] = 1u;
    const float inv = okl ? 1.f / l : 0.f;
    bf16* yo = YA + (rowbase + q) * 512 + h * 64 + 4 * hi;
#pragma unroll
    for (int g = 0; g < 4; ++g) {
        *(GAS v2u*)(yo + 8 * g) = (v2u){pg8::cvt_pk_bf16(o0[4 * g] * inv, o0[4 * g + 1] * inv), pg8::cvt_pk_bf16(o0[4 * g + 2] * inv, o0[4 * g + 3] * inv)};
        *(GAS v2u*)(yo + 32 + 8 * g) = (v2u){pg8::cvt_pk_bf16(o1[4 * g] * inv, o1[4 * g + 1] * inv), pg8::cvt_pk_bf16(o1[4 * g + 2] * inv, o1[4 * g + 3] * inv)};
    }
    __syncthreads();
    return flag[0] == 0u;
}
__device__ __forceinline__ void attn_phase(LAS unsigned char* lds, const bf16* Q, const bf16* K, const bf16* V, const unsigned* MASK, bf16* YA, int blk, int G, int tid, int wave, int lane) {
    const int vcu = (G % 8 == 0) ? (blk % 8) * (G / 8) + blk / 8 : blk;
#pragma unroll 1
    for (int pi = vcu; pi < 512; pi += G) {
#pragma unroll 1
        for (int half = 0; half < 2; ++half) {
            const int bh = pi >> 3, ii = pi & 7, qb = half ? 15 - ii : ii, b = bh >> 3, h = bh & 7;
            if (!attn_unit_fast(lds, Q, K, V, MASK, YA, b, h, qb, tid, wave, lane)) attn_unit<true>(lds, Q, K, V, MASK, YA, b, h, qb, tid, wave, lane);
        }
    }
}

constexpr int IX_REC = 2112, IX_B1 = 1024, IX_NEED = 1028, IX_TAU = 1032, IX_CNT = 1036, IX_W = 1040, IX_LIST = 1088, IX_LCAP = 256, IX_FLAG = 64 * IX_REC;
__device__ __forceinline__ unsigned key16_of(float s) { const _Float16 hf = (_Float16)s; const int h = (int)__builtin_bit_cast(short, hf); return (unsigned)(h ^ ((h >> 15) | 0x8000)) & 0xFFFFu; }
__device__ __forceinline__ float ix_relu(float x) { return __builtin_bit_cast(float, __builtin_elementwise_max(__builtin_bit_cast(int, x), 0)); }
#define IX_RELU(x) ix_relu(x)
template <int PASS, bool DIAG>
__device__ __forceinline__ void idx_tile(LAS unsigned char* rec, const bf16x8v (&af)[4][4], const bf16x8v (&bc)[4], unsigned* MASKb, int j, int rg, int kt, int lane) {
    const int n = lane & 31, hi = lane >> 5, s = kt * 32 + n;
    f32x16 accA, accB;
#define IX_CHAIN(dst, rt_) do { _Pragma("unroll") for (int i = 0; i < 16; ++i) dst[i] = 0.f; _Pragma("unroll") for (int ks = 0; ks < 4; ++ks) dst = MFMA32(af[rt_][ks], bc[ks], dst); } while (0)
    IX_CHAIN(accA, 0);
#pragma unroll
    for (int rt = 0; rt < 4; ++rt) {
        if (rt < 3) IX_CHAIN(accB, (rt < 3 ? rt + 1 : 3));
        LAS unsigned char* ra = rec + rt * 4 * IX_REC; LAS unsigned char* rb = ra + 2 * IX_REC;
        const f32x4 wa0 = *(const LAS f32x4*)(ra + IX_W), wa1 = *(const LAS f32x4*)(ra + IX_W + 16), wb0 = *(const LAS f32x4*)(rb + IX_W), wb1 = *(const LAS f32x4*)(rb + IX_W + 16);
        float sa0 = 0.f, sa1 = 0.f, sb0 = 0.f, sb1 = 0.f;
#pragma unroll
        for (int i = 0; i < 4; i += 2) {
            sa0 = __builtin_fmaf(IX_RELU(accA[i]), wa0[i], sa0); sa1 = __builtin_fmaf(IX_RELU(accA[i + 1]), wa0[i + 1], sa1);
            sb0 = __builtin_fmaf(IX_RELU(accA[8 + i]), wb0[i], sb0); sb1 = __builtin_fmaf(IX_RELU(accA[9 + i]), wb0[i + 1], sb1);
            sa0 = __builtin_fmaf(IX_RELU(accA[4 + i]), wa1[i], sa0); sa1 = __builtin_fmaf(IX_RELU(accA[5 + i]), wa1[i + 1], sa1);
            sb0 = __builtin_fmaf(IX_RELU(accA[12 + i]), wb1[i], sb0); sb1 = __builtin_fmaf(IX_RELU(accA[13 + i]), wb1[i + 1], sb1); }
        float sa = sa0 + sa1, sb = sb0 + sb1;
        asm volatile("" : "+v"(sa), "+v"(sb));
        accA = accB;
        const int qa = rg * 16 + 4 * rt + hi, qb = qa + 2;
        const bool va = !DIAG || s <= j * 64 + qa, vb = !DIAG || s <= j * 64 + qb;
        if (PASS == 1) {
            const unsigned ka = key16_of(sa) >> 8, kb = key16_of(sb) >> 8;
            if (va) __hip_atomic_fetch_add((LAS unsigned*)(ra + ka * 4), 1u, __ATOMIC_RELAXED, __HIP_MEMORY_SCOPE_WORKGROUP);
            if (vb) __hip_atomic_fetch_add((LAS unsigned*)(rb + kb * 4), 1u, __ATOMIC_RELAXED, __HIP_MEMORY_SCOPE_WORKGROUP);
        } else if (PASS == 2) {
            const unsigned ka = key16_of(sa), kb = key16_of(sb);
            const unsigned b1a = *(const LAS unsigned*)(ra + IX_B1), b1b = *(const LAS unsigned*)(rb + IX_B1);
            bool sela = va & ((ka >> 8) > b1a), selb = vb & ((kb >> 8) > b1b);
            if (va && (ka >> 8) == b1a) { __hip_atomic_fetch_add((LAS unsigned*)(ra + (ka & 255u) * 4), 1u, __ATOMIC_RELAXED, __HIP_MEMORY_SCOPE_WORKGROUP);
                const unsigned slot = __hip_atomic_fetch_add((LAS unsigned*)(ra + IX_CNT), 1u, __ATOMIC_RELAXED, __HIP_MEMORY_SCOPE_WORKGROUP);
                if (slot < (unsigned)IX_LCAP) *(LAS unsigned*)(ra + IX_LIST + slot * 4) = ((unsigned)s << 8) | (ka & 255u); else sela = true; }
            if (vb && (kb >> 8) == b1b) { __hip_atomic_fetch_add((LAS unsigned*)(rb + (kb & 255u) * 4), 1u, __ATOMIC_RELAXED, __HIP_MEMORY_SCOPE_WORKGROUP);
                const unsigned slot = __hip_atomic_fetch_add((LAS unsigned*)(rb + IX_CNT), 1u, __ATOMIC_RELAXED, __HIP_MEMORY_SCOPE_WORKGROUP);
                if (slot < (unsigned)IX_LCAP) *(LAS unsigned*)(rb + IX_LIST + slot * 4) = ((unsigned)s << 8) | (kb & 255u); else selb = true; }
            const unsigned long long ba = __ballot(sela), bb = __ballot(selb);
            if (lane == 0) {
                unsigned* mr = MASKb + (size_t)(j * 64 + rg * 16 + 4 * rt) * 128 + kt;
                mr[0] = (unsigned)ba; mr[128] = (unsigned)(ba >> 32); mr[256] = (unsigned)bb; mr[384] = (unsigned)(bb >> 32);
            }
        } else {
            const unsigned long long ba = __ballot(va & ((_Float16)sa >= *(const LAS _Float16*)(ra + IX_TAU))), bb = __ballot(vb & ((_Float16)sb >= *(const LAS _Float16*)(rb + IX_TAU)));
            if (lane == 0) {
                unsigned* mr = MASKb + (size_t)(j * 64 + rg * 16 + 4 * rt) * 128 + kt;
                mr[0] = (unsigned)ba; mr[128] = (unsigned)(ba >> 32); mr[256] = (unsigned)bb; mr[384] = (unsigned)(bb >> 32);
            }
        }
    }
#undef IX_CHAIN
}
template <int PASS>
__device__ __forceinline__ void idx_pass(LAS unsigned char* lds, const bf16x8v (&af)[4][4], const bf16* KIb, unsigned* MASKb, int j, int rg, int kh, int lane) {
    const int n = lane & 31, hi = lane >> 5;
    LAS unsigned char* rec = lds + (rg * 16 + hi) * IX_REC;
    bf16x8v bc[4], bn[4];
    int kt = kh;
#pragma unroll
    for (int ks = 0; ks < 4; ++ks) bc[ks] = *(const GAS bf16x8v*)(KIb + (size_t)(kt * 32 + n) * 64 + 16 * ks + 8 * hi);
#pragma unroll 1
    for (; kt < 2 * j; kt += 2) {
#pragma unroll
        for (int ks = 0; ks < 4; ++ks) bn[ks] = *(const GAS bf16x8v*)(KIb + (size_t)((kt + 2) * 32 + n) * 64 + 16 * ks + 8 * hi);
        idx_tile<PASS, false>(rec, af, bc, MASKb, j, rg, kt, lane);
#pragma unroll
        for (int ks = 0; ks < 4; ++ks) bc[ks] = bn[ks];
    }
    idx_tile<PASS, true>(rec, af, bc, MASKb, j, rg, kt, lane);
}
template <int LEVEL>
__device__ __forceinline__ void idx_scan(LAS unsigned char* lds, int wave, int lane) {
#pragma unroll 4
    for (int qq = 0; qq < 8; ++qq) {
        LAS unsigned char* rq = lds + (wave * 8 + qq) * IX_REC;
        const v4u hc = *(const LAS v4u*)(rq + 16 * lane);
        const unsigned cn[4] = {hc.x, hc.y, hc.z, hc.w};
        const unsigned need = LEVEL == 1 ? 256u : *(const LAS unsigned*)(rq + IX_NEED);
        const unsigned tot = cn[0] + cn[1] + cn[2] + cn[3];
        unsigned incl = tot;
#pragma unroll
        for (int o = 1; o < 64; o <<= 1) { const unsigned v = (unsigned)__shfl_down((int)incl, o); if (lane + o < 64) incl += v; }
        unsigned r = incl - tot; int found = -1; unsigned above = 0u;
#pragma unroll
        for (int k = 3; k >= 0; --k) { if (found < 0 && r < need && r + cn[k] >= need) { found = 4 * lane + k; above = r; } r += cn[k]; }
        if (found >= 0) {
            if (LEVEL == 1) { *(LAS unsigned*)(rq + IX_B1) = (unsigned)found; *(LAS unsigned*)(rq + IX_NEED) = need - above; }
            else { const unsigned key = (*(const LAS unsigned*)(rq + IX_B1) << 8) | (unsigned)found, hb = (key & 0x8000u) ? (key & 0x7FFFu) : (~key & 0xFFFFu);
                   *(LAS _Float16*)(rq + IX_TAU) = __builtin_bit_cast(_Float16, (unsigned short)hb); *(LAS unsigned*)(rq + IX_NEED) = (unsigned)found; }
        }
    }
}
__device__ __forceinline__ void idx_fixup(LAS unsigned char* lds, unsigned* MASKb, int j, int wave, int lane) {
#pragma unroll 1
    for (int qq = 0; qq < 8; ++qq) {
        const int ql = wave * 8 + qq; LAS unsigned char* rq = lds + ql * IX_REC;
        const unsigned cnt0 = *(const LAS unsigned*)(rq + IX_CNT), cnt = cnt0 < (unsigned)IX_LCAP ? cnt0 : (unsigned)IX_LCAP, b2 = *(const LAS unsigned*)(rq + IX_NEED);
        unsigned* mrow = MASKb + (size_t)(j * 64 + ql) * 128;
        for (unsigned e = lane; e < cnt; e += 64) { const unsigned en = *(const LAS unsigned*)(rq + IX_LIST + e * 4), sidx = en >> 8;
            if ((en & 255u) >= b2) __hip_atomic_fetch_or(mrow + (sidx >> 5), 1u << (sidx & 31u), __ATOMIC_RELAXED, __HIP_MEMORY_SCOPE_AGENT); }
    }
}
__device__ __forceinline__ void index_phase(LAS unsigned char* lds, const bf16* QI, const bf16* KI, const float* WI, unsigned* MASK, int blk, int G, int tid, int wave, int lane) {
    const int rg = wave >> 1, kh = wave & 1, r = lane & 31, hi = lane >> 5;
    const int qsr = 2 * (r >> 4) + ((r >> 2) & 1), hdr = (r & 3) + 4 * ((r >> 3) & 1);
#pragma unroll 1
    for (int p = blk; p < 256; p += G) {
#pragma unroll 1
        for (int half = 0; half < 2; ++half) {
            const int b = p >> 5, jj = p & 31, j = half ? 63 - jj : jj;
            const size_t rowbase = (size_t)b * SEQ;
            unsigned* MASKb = MASK + rowbase * 128;
            if (j < 4) {
                const int row = tid >> 3, t = j * 64 + row;
#pragma unroll 4
                for (int k = 0; k < 16; ++k) { const int w = (tid & 7) * 16 + k, d = t - 32 * w; MASKb[(size_t)t * 128 + w] = d >= 31 ? 0xFFFFFFFFu : d < 0 ? 0u : ((2u << d) - 1u); }
                continue;
            }
            bf16x8v af[4][4];
#pragma unroll
            for (int rt = 0; rt < 4; ++rt) {
                const size_t tq = rowbase + j * 64 + rg * 16 + 4 * rt + qsr;
#pragma unroll
                for (int ks = 0; ks < 4; ++ks) af[rt][ks] = *(const GAS bf16x8v*)(QI + tq * 512 + hdr * 64 + 16 * ks + 8 * hi);
            }
            const float wmine = WI[(rowbase + j * 64) * 8 + tid];
            const bf16* KIb = KI + rowbase * 64;
            __syncthreads();
            *(LAS float*)(lds + (tid >> 3) * IX_REC + IX_W + (tid & 7) * 4) = wmine;
#pragma unroll
            for (int k = 0; k < 8; ++k) *(LAS v4u*)(lds + (tid >> 3) * IX_REC + (tid & 7) * 128 + k * 16) = (v4u){0u, 0u, 0u, 0u};
            __syncthreads();
            idx_pass<1>(lds, af, KIb, MASKb, j, rg, kh, lane);
            __syncthreads();
            idx_scan<1>(lds, wave, lane);
            __syncthreads();
#pragma unroll
            for (int k = 0; k < 8; ++k) *(LAS v4u*)(lds + (tid >> 3) * IX_REC + (tid & 7) * 128 + k * 16) = (v4u){0u, 0u, 0u, 0u};
            if ((tid & 7) == 0) *(LAS unsigned*)(lds + (tid >> 3) * IX_REC + IX_CNT) = 0u;
            __syncthreads();
            idx_pass<2>(lds, af, KIb, MASKb, j, rg, kh, lane);
            asm volatile("s_waitcnt vmcnt(0)" ::: "memory");
            __syncthreads();
            idx_scan<2>(lds, wave, lane);
            __syncthreads();
            idx_fixup(lds, MASKb, j, wave, lane);
            { const int row = tid >> 3, t = j * 64 + row;
              for (int w = 2 * (j + 1) + (tid & 7); w < 128; w += 8) MASKb[(size_t)t * 128 + w] = 0u; }
        }
    }
}

constexpr int LR_WAVE = 16384, LR_AOFF = 8192, LR_XP = 144;
template <int PASS>
__device__ __forceinline__ void lru_phase(LAS unsigned char* lds, int layer, const bf16* XR, const bf16* GR, float* AGG, bf16* YB, int blk, int G, int wave, int lane) {
    const int hb = wave, c = hb * 64 + lane, n = lane & 31, hi = lane >> 5;
    LAS float* xib = (LAS float*)(lds + wave * LR_WAVE);
    LAS float* abuf = (LAS float*)(lds + wave * LR_WAVE + LR_AOFF);
    LAS unsigned char* xcb = lds + wave * LR_WAVE + LR_AOFF;
    bf16x8v wf[2][2][4];
    { const float* w_a = kin(7) + (size_t)(layer * 8 + hb) * 4096; const float* w_x = kin(9) + (size_t)(layer * 8 + hb) * 4096;
#pragma unroll
      for (int nt = 0; nt < 2; ++nt)
#pragma unroll
        for (int ks = 0; ks < 4; ++ks) { float a[8], x[8];
#pragma unroll
            for (int jj = 0; jj < 8; ++jj) { const int idx = (16 * ks + 8 * hi + jj) * 64 + 32 * nt + n; a[jj] = w_a[idx]; x[jj] = w_x[idx]; }
            wf[0][nt][ks] = pack_frag(a[0], a[1], a[2], a[3], a[4], a[5], a[6], a[7]); wf[1][nt][ks] = pack_frag(x[0], x[1], x[2], x[3], x[4], x[5], x[6], x[7]); } }
    const float* cwp = kin(5);
    const float cw0 = cwp[(layer * 4 + 0) * 512 + c], cw1 = cwp[(layer * 4 + 1) * 512 + c], cw2 = cwp[(layer * 4 + 2) * 512 + c], cw3 = cwp[(layer * 4 + 3) * 512 + c];
    const float cb = kin(6)[layer * 512 + c];
    float ba[2], bx[2], sp8[2];
#pragma unroll
    for (int nt = 0; nt < 2; ++nt) { const int ce = layer * 512 + hb * 64 + 32 * nt + n; ba[nt] = kin(8)[ce]; bx[nt] = kin(10)[ce];
        const float lam = kin(11)[ce]; sp8[nt] = 8.f * (fmaxf(-lam, 0.f) + log1pf(__expf(-fabsf(lam)))); }
#pragma unroll 1
    for (int u = blk; u < NB * 32; u += G) {
        const int b = u >> 5, ch = u & 31, row0 = b * SEQ + ch * 128;
        float x0 = 0.f, x1 = 0.f, x2 = 0.f;
        if (ch > 0) { x0 = bf2f(XR[(size_t)(row0 - 3) * 512 + c]); x1 = bf2f(XR[(size_t)(row0 - 2) * 512 + c]); x2 = bf2f(XR[(size_t)(row0 - 1) * 512 + c]); }
        float h = 0.f, P = 1.f;
        if (PASS == 2) {
#pragma unroll 1
            for (int j0 = 0; j0 < ch; j0 += 8) { f32x2 ag[8];
#pragma unroll
                for (int k = 0; k < 8; ++k) ag[k] = j0 + k < ch ? *(const GAS f32x2*)(AGG + ((size_t)(b * 32 + j0 + k) * 512 + c) * 2) : (f32x2){1.f, 0.f};
#pragma unroll
                for (int k = 0; k < 8; ++k) h = ag[k][0] * h + ag[k][1]; } }
#pragma unroll 1
        for (int sc = 0; sc < 4; ++sc) {
            const int r0 = row0 + sc * 32;
#pragma unroll 1
            for (int th = 0; th < 32; th += 16) {
            float xin[16];
#pragma unroll
            for (int t = 0; t < 16; ++t) xin[t] = bf2f(XR[(size_t)(r0 + th + t) * 512 + c]);
#pragma unroll
            for (int tl = 0; tl < 16; ++tl) {
                const int t = th + tl;
                const float xt = xin[tl];
                const float xc = cw0 * x0 + cw1 * x1 + cw2 * x2 + cw3 * xt + cb;
                x0 = x1; x1 = x2; x2 = xt;
                xib[t * 64 + lane] = xc;
                *(LAS unsigned short*)(xcb + t * LR_XP + lane * 2) = (unsigned short)f2bf(xc);
            } }
            LDS_WAIT();
            bf16x8v af[4];
#pragma unroll
            for (int ks = 0; ks < 4; ++ks) af[ks] = *(const LAS bf16x8v*)(xcb + n * LR_XP + (16 * ks + 8 * hi) * 2);
            LDS_WAIT();
            f32x16 ga[2], gx[2];
#pragma unroll
            for (int nt = 0; nt < 2; ++nt) {
#pragma unroll
                for (int i = 0; i < 16; ++i) { ga[nt][i] = 0.f; gx[nt][i] = 0.f; }
#pragma unroll
                for (int ks = 0; ks < 4; ++ks) { ga[nt] = MFMA32(af[ks], wf[0][nt][ks], ga[nt]); gx[nt] = MFMA32(af[ks], wf[1][nt][ks], gx[nt]); } }
#pragma unroll
            for (int nt = 0; nt < 2; ++nt)
#pragma unroll
                for (int i = 0; i < 16; ++i) { const int tt = 8 * (i >> 2) + 4 * hi + (i & 3), li = tt * 64 + 32 * nt + n;
                    const float r = sigm(ga[nt][i] + ba[nt]), ig = sigm(gx[nt][i] + bx[nt]);
                    const float la = -sp8[nt] * r, a = pg8::fexp(la), y = 2.f * la;
                    const float em = -y * (1.f + y * (0.5f + y * (0.16666667f + y * (0.041666668f + y * (0.0083333338f + y * (0.0013888889f + y * 0.0001984127f))))));
                    const float xc = xib[li];
                    const float em2 = y > -0.25f ? em : 1.f - a * a;
                    abuf[li] = a; xib[li] = __builtin_amdgcn_sqrtf(fmaxf(em2, 0.f)) * (ig * xc); }
            LDS_WAIT();
#pragma unroll 1
            for (int th = 0; th < 32; th += 16) {
                float gin[16];
                if (PASS == 2) {
#pragma unroll
                    for (int t = 0; t < 16; ++t) gin[t] = bf2f(GR[(size_t)(r0 + th + t) * 512 + c]); }
#pragma unroll
                for (int t = 0; t < 16; ++t) {
                    const float a = abuf[(th + t) * 64 + lane], in = xib[(th + t) * 64 + lane];
                    h = a * h + in; P *= a;
                    if (PASS == 2) YB[(size_t)(r0 + th + t) * 512 + c] = (bf16)f2bf(h * gin[t]);
                }
            }
            LDS_WAIT();
        }
        if (PASS == 1) *(GAS f32x2*)(AGG + ((size_t)u * 512 + c) * 2) = (f32x2){P, h};
    }
}

constexpr int GM_RMS = 0, GM_IMG = 512, GM_P = 272, GM_WAVE = 64 * GM_P;
__device__ __forceinline__ void gmlp_phase(LAS unsigned char* lds, int layer, const bf16* ZU, const bf16* ZV, bf16* YC, int blk, int G, int tid, int wave, int lane) {
    LAS float* rms = (LAS float*)(lds + GM_RMS);
    LAS unsigned char* img = lds + GM_IMG + wave * GM_WAVE;
    const int g = wave, n = lane & 31, hi = lane >> 5;
    const float* wsp = kin(13) + (size_t)(layer * 8 + g) * 128 * 128;
    const float* bsp = kin(14) + (size_t)(layer * 8 + g) * 128;
    const int wch = lane & 7, wtk = lane >> 3;
    float gv[8];
#pragma unroll
    for (int i = 0; i < 8; ++i) gv[i] = kin(12)[layer * 512 + g * 64 + wch * 8 + i];
#pragma unroll 1
    for (int u = blk; u < NB * 32; u += G) {
        const int row0 = u * 128;
        __syncthreads();
        { v4u zr[16];
#pragma unroll
          for (int i = 0; i < 16; ++i) zr[i] = *(const GAS v4u*)(ZV + (size_t)(row0 + wave * 16 + i) * 512 + lane * 8);
          float mine = 0.f;
#pragma unroll
          for (int i = 0; i < 16; ++i) { float a[8]; unpack8(zr[i], a); float ss = 0.f;
#pragma unroll
              for (int k = 0; k < 8; ++k) ss += a[k] * a[k];
              ss = wave_sum(ss);
              if (lane == i) mine = ss; }
          if (lane < 16) rms[wave * 16 + lane] = 1.f / sqrtf(mine * (1.f / 512.f) + EPS); }
        __syncthreads();
        v4u zi[16];
#pragma unroll
        for (int i = 0; i < 16; ++i) zi[i] = *(const GAS v4u*)(ZV + (size_t)(row0 + i * 8 + wtk) * 512 + g * 64 + wch * 8);
#pragma unroll
        for (int i = 0; i < 16; ++i) { const int s = i * 8 + wtk; float a[8]; unpack8(zi[i], a);
            const float rs = rms[s];
#pragma unroll
            for (int k = 0; k < 8; ++k) *(LAS unsigned short*)(img + (wch * 8 + k) * GM_P + s * 2) = (unsigned short)f2bf(a[k] * rs * gv[k]); }
        LDS_WAIT();
#pragma unroll
        for (int mt = 0; mt < 4; ++mt) {
            f32x16 acc[2];
#pragma unroll
            for (int i = 0; i < 16; ++i) { acc[0][i] = 0.f; acc[1][i] = 0.f; }
            const int t = 32 * mt + n;
#pragma unroll
            for (int ks = 0; ks < 2 * (mt + 1); ++ks) {
                const int s0 = 16 * ks + 8 * hi;
                const f32x4 wa = *(const GAS f32x4*)(wsp + t * 128 + s0), wb = *(const GAS f32x4*)(wsp + t * 128 + s0 + 4);
                float w[8] = {wa[0], wa[1], wa[2], wa[3], wb[0], wb[1], wb[2], wb[3]};
                if (ks >= 2 * mt) {
#pragma unroll
                    for (int k = 0; k < 8; ++k) w[k] = (s0 + k <= t) ? w[k] : 0.f; }
                const bf16x8v af = pack_frag(w[0], w[1], w[2], w[3], w[4], w[5], w[6], w[7]);
#pragma unroll
                for (int nt = 0; nt < 2; ++nt) { const bf16x8v bfr = *(const LAS bf16x8v*)(img + (32 * nt + n) * GM_P + s0 * 2); acc[nt] = MFMA32(af, bfr, acc[nt]); }
            }
#pragma unroll
            for (int i = 0; i < 16; ++i) { const int tt = 32 * mt + 8 * (i >> 2) + 4 * hi + (i & 3); const float bs = bsp[tt];
#pragma unroll
                for (int nt = 0; nt < 2; ++nt) { const size_t o = (size_t)(row0 + tt) * 512 + g * 64 + 32 * nt + n;
                    YC[o] = (bf16)f2bf(bf2f(ZU[o]) * (acc[nt][i] + bs)); } }
        }
    }
}

#define IN(k) (lo <= (k) && (k) < hi)
#ifndef REP_B
#define REP_B 1
#endif
#define SEAM(k) do { if (IN(k) && IN((k) + 1)) { for (int rb_ = 0; rb_ < REP_B; ++rb_) xcd_barrier(bar); } } while (0)
#define WP(T, off) ((T*)(ws + (off)))
#define PH_LOCAL() int G = gridDim.x, blk = blockIdx.x; asm volatile("" : "+s"(G), "+s"(blk)); const int NGW = G * NWAVES; int tid = wave0 * 64 + lane_id(); asm volatile("" : "+v"(tid)); \
    const int lane = tid & 63, wave = __builtin_amdgcn_readfirstlane(tid >> 6), gw = blk * NWAVES + wave; (void)lane; (void)gw; (void)NGW
template <int layer>
__device__ __forceinline__ void layer_body(LAS unsigned char* lds, const XcdBarrier& bar, const int lo, const int hi, const int wave0) {
        const int pb = 1 + layer * PH_PER_LAYER;
#define WL(off) ((const bf16*)(ws + WS_W + (size_t)layer * W_LAYER + (off)))

        if (IN(pb + 0)) {
            unsigned char* ws = kws(); PH_LOCAL();
            pg8::Gemm g{WP(bf16, WS_H), WL(WO_IN), M, NA, D}; pg8::StaticOrder S; S.init(M, NA, G, blk);
            pg8::EpiInA E{WP(bf16, WS_Q), WP(bf16, WS_K), WP(bf16, WS_V), WP(bf16, WS_QI), WP(bf16, WS_XR), WP(bf16, WS_GR), WP(bf16, WS_ZU), WP(bf16, WS_ZV), WP(bf16, WS_KI), WP(float, WS_WI), WP(float, WS_ROPE)};
            for (int rep_ = 0; rep_ < REP_G; ++rep_) { pg8::gemm_phase<pg8::EpiInA, pg8::StaticOrder, true, true>(lds, g, S, E, wave0); }
        }
        SEAM(pb + 0);
        if (IN(pb + 1)) {
            { unsigned char* ws = kws(); PH_LOCAL();
              for (int rep_ = 0; rep_ < REP_I; ++rep_) { index_phase(lds, WP(bf16, WS_QI), WP(bf16, WS_KI), WP(float, WS_WI), WP(unsigned, WS_SEL), blk, G, tid, wave, lane); __syncthreads(); } }
            __syncthreads();
            { unsigned char* ws = kws(); PH_LOCAL();
              for (int rep_ = 0; rep_ < REP_M; ++rep_) { lru_phase<1>(lds, layer, WP(bf16, WS_XR), WP(bf16, WS_GR), WP(float, WS_AGG), WP(bf16, WS_ZU), blk, G, wave, lane); } }
            __syncthreads();
            { unsigned char* ws = kws(); PH_LOCAL();
              for (int rep_ = 0; rep_ < REP_M; ++rep_) { gmlp_phase(lds, layer, WP(bf16, WS_ZU), WP(bf16, WS_ZV), WP(bf16, WS_YC), blk, G, tid, wave, lane); } }
        }
        SEAM(pb + 1);
        if (IN(pb + 2)) {
            __syncthreads();
            { unsigned char* ws = kws(); PH_LOCAL();
              for (int rep_ = 0; rep_ < REP_A; ++rep_) { attn_phase(lds, WP(bf16, WS_Q), WP(bf16, WS_K), WP(bf16, WS_V), WP(unsigned, WS_SEL), WP(bf16, WS_QI), blk, G, tid, wave, lane); __syncthreads(); } }
            __syncthreads();
            { unsigned char* ws = kws(); PH_LOCAL();
              for (int rep_ = 0; rep_ < REP_M; ++rep_) { lru_phase<2>(lds, layer, WP(bf16, WS_XR), WP(bf16, WS_GR), WP(float, WS_AGG), WP(bf16, WS_ZU), blk, G, wave, lane); } }
        }
        SEAM(pb + 2);
        if (IN(pb + 3)) {
            unsigned char* ws = kws(); PH_LOCAL();
            pg8::Gemm g{WP(bf16, WS_H), WL(WO_IN) + (size_t)NA * D, M, NG, D}; pg8::StaticOrder S; S.init(M, NG, G, blk);
            pg8::EpiGen<4> E{WP(bf16, WS_G), NG, nullptr};
            for (int rep_ = 0; rep_ < REP_G; ++rep_) { pg8::gemm_phase<pg8::EpiGen<4>, pg8::StaticOrder, true, true>(lds, g, S, E, wave0); }
        }
        SEAM(pb + 3);
        if (IN(pb + 4)) {
            unsigned char* ws = kws(); PH_LOCAL();
            pg8::Gemm g{WP(bf16, WS_QI), WL(WO_BR), 3 * M, 3 * D, 512}; pg8::MergeOrder S; S.so.init(M, D, G, blk);
            pg8::EpiMerge2 E{WP(bf16, WS_H), WP(bf16, WS_G)};
            for (int rep_ = 0; rep_ < REP_G * REP_MG; ++rep_) { pg8::gemm_phase<pg8::EpiMerge2, pg8::MergeOrder, true, true>(lds, g, S, E, wave0); }
        }
        SEAM(pb + 4);
        if (IN(pb + 5)) {
            unsigned char* ws = kws(); PH_LOCAL();
            pg8::Gemm g{WP(bf16, WS_H), WL(WO_OUT), M, D, D}; pg8::StaticOrder S; S.init(M, D, G, blk);
            pg8::EpiGen<0> E{WP(bf16, WS_T), D, nullptr};
            for (int rep_ = 0; rep_ < REP_G; ++rep_) { pg8::gemm_phase<pg8::EpiGen<0>, pg8::StaticOrder, true, true>(lds, g, S, E, wave0); }
        }
        SEAM(pb + 5);
        if (IN(pb + 6)) { unsigned char* ws = kws(); PH_LOCAL();  _Float16* X = (_Float16*)kout(); if (layer == 0) norm_phase<float, _Float16>(kin(0), X, WP(bf16, WS_T), kin(17) + layer * D, kin(18) + layer * D, WP(bf16, WS_H), 0, gw, NGW, lane);
            else norm_phase<_Float16, _Float16>(X, X, WP(bf16, WS_T), kin(17) + layer * D, kin(18) + layer * D, WP(bf16, WS_H), 0, gw, NGW, lane); }
        SEAM(pb + 6);
        if (IN(pb + 7)) {
            unsigned char* ws = kws(); PH_LOCAL();
            pg8::Gemm g{WP(bf16, WS_H), WL(WO_UP), M, FF, D}; pg8::StaticOrder S; S.init(M, FF, G, blk);
            pg8::EpiGen<1> E{WP(bf16, WS_U), FF, nullptr};
            for (int rep_ = 0; rep_ < REP_G; ++rep_) { pg8::gemm_phase<pg8::EpiGen<1>, pg8::StaticOrder, true, true>(lds, g, S, E, wave0); }
        }
        SEAM(pb + 7);
        if (IN(pb + 8)) {
            unsigned char* ws = kws(); PH_LOCAL();
            pg8::Gemm g{WP(bf16, WS_U), WL(WO_DN), M, D, FF}; pg8::StaticOrder S; S.init(M, D, G, blk);
            pg8::EpiGen<0> E{WP(bf16, WS_T2), D, nullptr};
#ifndef DBG_NOF
            for (int rep_ = 0; rep_ < REP_G; ++rep_) { pg8::gemm_phase<pg8::EpiGen<0>, pg8::StaticOrder, true, true>(lds, g, S, E, wave0); }
#else
            { const int tid = wave0 * 64 + lane_id(); for (size_t e = (size_t)(blk * 512 + tid) * 8; e < (size_t)M * D; e += (size_t)G * 512 * 8) *(GAS v4u*)(WP(bf16, WS_T2) + e) = (v4u){0u, 0u, 0u, 0u}; }
#endif
        }
        SEAM(pb + 8);
        if (IN(pb + 9)) { unsigned char* ws = kws(); PH_LOCAL();  _Float16* X = (_Float16*)kout(); norm_phase<_Float16, _Float16>(X, layer + 1 < NLAYER ? X : WP(_Float16, WS_XPARK), WP(bf16, WS_T2), kin(21) + layer * D, nullptr, WP(bf16, WS_H), 1, gw, NGW, lane); }
        SEAM(pb + 9);
        if (IN(pb + 10)) {
            unsigned char* ws = kws(); PH_LOCAL();
            pg8::Gemm g{WP(bf16, WS_H), WL(WO_PG), M, D, D}; pg8::StaticOrder S; S.init(M, D, G, blk);
#ifdef DBG_S0
            zero_rows(WP(bf16, WS_S), blk, G, wave0 * 64 + lane_id()); zero_rows(WP(bf16, WS_S) + (size_t)M * 512, blk, G, wave0 * 64 + lane_id());
#else
#ifdef DBG_S2T
            pg8::EpiGen<2> E{WP(bf16, WS_T3), D, nullptr};
#else
            pg8::EpiGen<2> E{WP(bf16, WS_S), D, nullptr};
#endif
            for (int rep_ = 0; rep_ < REP_G; ++rep_) { pg8::gemm_phase<pg8::EpiGen<2>, pg8::StaticOrder, true, true>(lds, g, S, E, wave0); }
#endif
        }
        if (IN(pb + 10) && IN(pb + 11)) { asm volatile("s_waitcnt vmcnt(0)" ::: "memory"); __syncthreads(); }
        if (IN(pb + 11)) {
            unsigned char* ws = kws(); PH_LOCAL();
            pg8::Gemm g{WP(bf16, WS_P) + (size_t)layer * M * PLE, WL(WO_PLE), M, D, PLE}; pg8::StaticOrder S; S.init(M, D, G, blk);
#ifdef DBG_S2T
#elif defined(DBG_P0)
            pg8::EpiGen<0> E{WP(bf16, WS_T3), D, WP(bf16, WS_S)};
            for (int rep_ = 0; rep_ < REP_G; ++rep_) { pg8::gemm_phase<pg8::EpiGen<0>, pg8::StaticOrder, true, true>(lds, g, S, E, wave0); }
#elif !defined(DBG_NOP)
            pg8::EpiGen<3> E{WP(bf16, WS_T3), D, WP(bf16, WS_S)};
            for (int rep_ = 0; rep_ < REP_G; ++rep_) { pg8::gemm_phase<pg8::EpiGen<3>, pg8::StaticOrder, true, true>(lds, g, S, E, wave0); }
#else
            { const int tid = wave0 * 64 + lane_id(); for (size_t e = (size_t)(blk * 512 + tid) * 8; e < (size_t)M * D; e += (size_t)G * 512 * 8) *(GAS v4u*)(WP(bf16, WS_T3) + e) = (v4u){0u, 0u, 0u, 0u}; }
#endif
        }
        SEAM(pb + 11);
        if (IN(pb + 12)) {
            unsigned char* ws = kws(); PH_LOCAL();
            if (layer + 1 < NLAYER) { _Float16* X = (_Float16*)kout(); norm_phase<_Float16, _Float16>(X, X, WP(bf16, WS_T3), kin(24) + layer * D, kin(3) + (layer + 1) * D, WP(bf16, WS_H), 0, gw, NGW, lane); }
            else norm_phase<_Float16, float>(WP(_Float16, WS_XPARK), kout(), WP(bf16, WS_T3), kin(24) + layer * D, nullptr, WP(bf16, WS_H), 2, gw, NGW, lane);
        }
        SEAM(pb + 12);
    }

__global__ void __launch_bounds__(NWAVES * 64, 2) fwd(Args args) {
    extern __shared__ __attribute__((aligned(16))) unsigned char lds_raw[];
    LAS unsigned char* lds = (LAS unsigned char*)lds_raw;
    volatile LAS unsigned* MISC = (volatile LAS unsigned*)(lds + MISC_OFF);
    const int wave0 = __builtin_amdgcn_readfirstlane((int)(threadIdx.x >> 6));
    if (wave0 == 0) { const int l = lane_id(); if (l < 32) MISC[l] = 0u; }
    __syncthreads();
    const int lo = args.ph_lo, hi = args.ph_hi;
    XcdBarrier bar; bar.bar = (unsigned*)(kws() + WS_CTL) + CW_BAR; bar.x = 0; bar.st = nullptr; bar.w0 = wave0;
    if (hi - lo > 1) bar = xcd_barrier_post((unsigned*)(kws() + WS_CTL) + CW_BAR, MISC + 8, wave0);

    if (IN(0)) for (int rpp_ = 0; rpp_ < REP_PRO; ++rpp_) {
        unsigned char* ws = kws(); PH_LOCAL();
        LAS float* scr = (LAS float*)(lds + wave * 16384);
        constexpr int I_IN = 16 * (NIN / 32), I_BR = 8 * 32, I_OUT = 16 * 32, I_UP = 16 * 128, I_DN = 64 * 32, I_PLE = 4 * 32, I_PG = 16 * 32;
        constexpr int I_LAYER = I_IN + 3 * I_BR + I_OUT + I_UP + I_DN + I_PLE + I_PG;
        for (int it = gw; it < NLAYER * I_LAYER; it += NGW) {
            const int layer = it / I_LAYER; int r = it % I_LAYER;
            unsigned char* wl = ws + WS_W + (size_t)layer * W_LAYER;
            if (r < I_IN) { transpose_item(kin(4) + (size_t)layer * D * INW, D, INW, (bf16*)(wl + WO_IN), NIN / 32, scr, r, lane, MapIn{}); continue; } r -= I_IN;
            if (r < 3 * I_BR) { const int n = r / I_BR; transpose_item(kin(15) + ((size_t)layer * 3 + n) * 512 * D, 512, D, (bf16*)(wl + WO_BR) + (size_t)n * D * 512, D / 32, scr, r % I_BR, lane, MapIdent{0}); continue; } r -= 3 * I_BR;
            if (r < I_OUT) { transpose_item(kin(16) + (size_t)layer * D * D, D, D, (bf16*)(wl + WO_OUT), D / 32, scr, r, lane, MapIdent{0}); continue; } r -= I_OUT;
            if (r < I_UP) { transpose_item(kin(19) + (size_t)layer * D * FF, D, FF, (bf16*)(wl + WO_UP), FF / 32, scr, r, lane, MapIdent{0}); continue; } r -= I_UP;
            if (r < I_DN) { transpose_item(kin(20) + (size_t)layer * FF * D, FF, D, (bf16*)(wl + WO_DN), D / 32, scr, r, lane, MapIdent{0}); continue; } r -= I_DN;
            if (r < I_PLE) { transpose_item(kin(22) + (size_t)layer * PLE * D, PLE, D, (bf16*)(wl + WO_PLE), D / 32, scr, r, lane, MapIdent{0}); continue; } r -= I_PLE;
            transpose_item(kin(23) + (size_t)layer * D * D, D, D, (bf16*)(wl + WO_PG), D / 32, scr, r, lane, MapIdent{0});
        }
        { const int* pos = (const int*)kin(2); float* rope = WP(float, WS_ROPE);
          for (int e = blk * 512 + tid; e < M * 8; e += G * 512) { const int row = e >> 3, jf = e & 7;
              const float invf = jf == 0 ? 1.0f : jf == 1 ? 0.1939227432012558f : jf == 2 ? 0.03760603070259094f : jf == 3 ? 0.007292664609849453f : jf == 4 ? 0.0014142135623842478f : jf == 5 ? 0.00027424818836152554f : jf == 6 ? 5.318296098266728e-05f : 1.0313386155758053e-05f;
              const float ang = (float)pos[row] * invf; float s, c; sincos_d(ang, s, c);
              *(GAS f32x2*)(rope + (size_t)row * 16 + jf * 2) = (f32x2){c, s}; } }
        { const float* p = kin(1); bf16* Pb = WP(bf16, WS_P);
#pragma unroll 4
          for (size_t e = (size_t)(blk * 512 + tid) * 8; e < (size_t)NLAYER * M * PLE; e += (size_t)G * 512 * 8) {
              const f32x4 a = *(const GAS f32x4*)(p + e), b2 = *(const GAS f32x4*)(p + e + 4);
              const float o[8] = {a[0], a[1], a[2], a[3], b2[0], b2[1], b2[2], b2[3]};
              *(GAS v4u*)(Pb + e) = pack8(o); } }
        norm_phase<float, float>(kin(0), nullptr, nullptr, nullptr, kin(3), WP(bf16, WS_H), 0, gw, NGW, lane);
    }
    SEAM(0);

    layer_body<0>(lds, bar, lo, hi, wave0);
    layer_body<1>(lds, bar, lo, hi, wave0);
#undef IN
#undef SEAM
}

extern "C" void kernel_launch(void* const* d_in, const int* in_sizes, int n_in, void* d_out, int out_size, void* d_ws, size_t ws_size, hipStream_t stream) {
    static int grid = 0;
    if (grid == 0) {
        if (n_in != 25 || in_sizes[0] != M * D || out_size != M * D || ws_size < WS_END) { fprintf(stderr, "kernel_launch: unexpected shapes: n_in %d in0 %d out %d ws %zu (need %zu)\n", n_in, n_in > 0 ? in_sizes[0] : -1, out_size, ws_size, (size_t)WS_END); grid = -1; return; }
        int dev = 0, cus = 0, per_cu = 0;
        if (hipGetDevice(&dev) != hipSuccess || hipDeviceGetAttribute(&cus, hipDeviceAttributeMultiprocessorCount, dev) != hipSuccess) { grid = -1; return; }
        if (hipFuncSetAttribute((const void*)fwd, hipFuncAttributeMaxDynamicSharedMemorySize, LDS_BYTES) != hipSuccess) { fprintf(stderr, "kernel_launch: hipFuncSetAttribute failed\n"); grid = -1; return; }
        if (hipOccupancyMaxActiveBlocksPerMultiprocessor(&per_cu, (const void*)fwd, NWAVES * 64, LDS_BYTES) != hipSuccess || per_cu < 1) { fprintf(stderr, "kernel_launch: occupancy query reports %d\n", per_cu); }
        (void)hipGetLastError();
        grid = cus;
    }
    if (grid < 0) return;
    if (hipMemsetAsync((char*)d_ws + WS_CTL, 0, CTL_ZERO_BYTES, stream) != hipSuccess) return;
    Args a{};
    for (int i = 0; i < 25; ++i) a.in[i] = (const float*)d_in[i];
    a.out = (float*)d_out; a.ws = (unsigned char*)d_ws;
#if MK_ONE_LAUNCH
    a.ph_lo = 0; a.ph_hi = NPH;
    hipLaunchKernelGGL(fwd, dim3(grid), dim3(NWAVES * 64), LDS_BYTES, stream, a);
#else
    for (int ph = 0; ph < NPH; ++ph) { a.ph_lo = ph; a.ph_hi = ph + 1; hipLaunchKernelGGL(fwd, dim3(grid), dim3(NWAVES * 64), LDS_BYTES, stream, a); }
#endif
}
```

```cpp
#include <hip/hip_runtime.h>
#include <cstdio>
#include <cstdint>
namespace pg8 {
#define PG8_LAS __attribute__((address_space(3)))
typedef unsigned short bf16_t;
typedef short bf16x8 __attribute__((ext_vector_type(8)));
typedef float f32x4 __attribute__((ext_vector_type(4)));
typedef unsigned u32x4 __attribute__((ext_vector_type(4)));
constexpr int BM = 256, BK = 64, HALF = 128, HTB = HALF * BK * 2  , STAGE_BYTES = 8 * HTB, NXCD = 8, WGM = 8;

__host__ __device__ __forceinline__ int lds_byte(int r, int c) { const int st = (r >> 4) * 2 + (c >> 5), rr = r & 15, cc = c & 31, ob = rr * 64 + cc * 2; return st * 1024 + (ob ^ (((ob >> 9) & 1) << 5)); }
__host__ __device__ __forceinline__ void stage_rc(int b, int& R, int& C) { const int st = b / 1024, sb = b % 1024, swz = sb ^ (((sb >> 9) & 1) << 5); R = (st >> 1) * 16 + swz / 64; C = (st & 1) * 32 + (swz % 64) / 2; }
__host__ __device__ __forceinline__ int perm32(int rho) { const int n = rho >> 4, i = rho & 15; return 8 * (i >> 2) + 4 * n + (i & 3); }

struct Unit { int pm, pn; };
struct Gemm { const bf16_t* A; const bf16_t* Bt; int M, N, K; };

struct StaticOrder {
    int nM, nN, nwg, G, c;
    __host__ __device__ void init(int M, int N, int G_, int c_) { nM = M / BM; nN = N / BM; nwg = nM * nN; G = G_; c = c_; }
    __host__ __device__ bool next(int i, Unit& u) const {
        const long L = (long)i * G + c; if (L >= nwg) return false;
        int wgid = (int)L; { const int q = nwg / NXCD, r = nwg % NXCD, xcd = wgid % NXCD, off = wgid / NXCD; wgid = (xcd < r ? xcd * (q + 1) : r * (q + 1) + (xcd - r) * q) + off; }
        const int nig = WGM * nN, gid = wgid / nig, fm = gid * WGM, gsz = (nM - fm) < WGM ? (nM - fm) : WGM;
        u.pm = fm + ((wgid % nig) % gsz); u.pn = (wgid % nig) / gsz; return true;
    }
    __device__ __forceinline__ void a_ready(const Unit&) const {}
    __device__ __forceinline__ void done(const Unit&) const {}
};


typedef float f32x2_t __attribute__((ext_vector_type(2))); typedef __bf16 bf16x2_t __attribute__((ext_vector_type(2)));
__device__ __forceinline__ unsigned cvt_pk_bf16(float lo, float hi) { f32x2_t v = {lo, hi}; bf16x2_t b = __builtin_convertvector(v, bf16x2_t); return __builtin_bit_cast(unsigned, b); }
__device__ __forceinline__ float bflo(unsigned w) { return __builtin_bit_cast(float, w << 16); }
__device__ __forceinline__ float bfhi(unsigned w) { return __builtin_bit_cast(float, w & 0xffff0000u); }
__device__ __forceinline__ float fexp(float x) { return __builtin_amdgcn_exp2f(x * 1.4426950408889634f); }
__device__ __forceinline__ float sigm(float x) { return __builtin_amdgcn_rcpf(1.f + fexp(-x)); }
__device__ __forceinline__ float gelu_tanh(float x) { const float u = 0.7978845608028654f * (x + 0.044715f * x * x * x); return x * __builtin_amdgcn_rcpf(1.f + fexp(-2.f * u)); }
__device__ __forceinline__ void unpack8(const u32x4 a, float (&v)[8]) { v[0] = bflo(a.x); v[1] = bfhi(a.x); v[2] = bflo(a.y); v[3] = bfhi(a.y); v[4] = bflo(a.z); v[5] = bfhi(a.z); v[6] = bflo(a.w); v[7] = bfhi(a.w); }
__device__ __forceinline__ u32x4 pack8(const float (&v)[8]) { u32x4 w; w.x = cvt_pk_bf16(v[0], v[1]); w.y = cvt_pk_bf16(v[2], v[3]); w.z = cvt_pk_bf16(v[4], v[5]); w.w = cvt_pk_bf16(v[6], v[7]); return w; }

template <int MODE  > struct EpiGen {
    static constexpr bool PERM = true, AFTER_DRAIN = false, CHAIN = false;
    bf16_t* O; int ldc; const bf16_t* aux;
    __device__ __forceinline__ void operator()(const f32x4 (&acc)[2][2][4][2], const Unit& u, int wr, int wc, int fr, int fq) const {
        const int row0 = u.pm * BM + wr * 64 + fr, col0 = u.pn * BM + wc * 32 + 8 * fq;
#pragma unroll
        for (int ai = 0; ai < 2; ++ai) {
            u32x4 ax[4][2];
            if (MODE == 3) {
#pragma unroll
                for (int m = 0; m < 4; ++m)
#pragma unroll
                    for (int bj = 0; bj < 2; ++bj) ax[m][bj] = *(const u32x4*)(aux + (size_t)(row0 + ai * HALF + m * 16) * ldc + col0 + bj * HALF); }
#pragma unroll
            for (int m = 0; m < 4; ++m) { const size_t ro = (size_t)(row0 + ai * HALF + m * 16) * ldc + col0;
#pragma unroll
                for (int bj = 0; bj < 2; ++bj) { const f32x4 v0 = acc[ai][bj][m][0], v1 = acc[ai][bj][m][1];
                    float v[8] = {v0[0], v0[1], v0[2], v0[3], v1[0], v1[1], v1[2], v1[3]};
                    if (MODE == 1) {
#pragma unroll
                        for (int k = 0; k < 8; ++k) { const float r = fmaxf(v[k], 0.f); v[k] = r * r; } }
                    if (MODE == 2) {
#pragma unroll
                        for (int k = 0; k < 8; ++k) v[k] = sigm(v[k]); }
                    if (MODE == 4) {
#pragma unroll
                        for (int k = 0; k < 8; ++k) v[k] = fmaxf(sigm(v[k]), 6.103515625e-05f); }
                    if (MODE == 3) { float a[8]; unpack8(ax[m][bj], a);
#pragma unroll
                        for (int k = 0; k < 8; ++k) v[k] *= a[k]; }
                    *(u32x4*)(O + ro + bj * HALF) = pack8(v); } }
            if (MODE == 3) __builtin_amdgcn_sched_barrier(0); }
    }
};

struct EpiInA {
    static constexpr bool PERM = true, AFTER_DRAIN = false, CHAIN = false;
    bf16_t *Q, *Kb, *V, *QI, *XR, *GR, *ZU, *ZV, *KI; float* WI; const float* rope;
    __device__ __forceinline__ void operator()(const f32x4 (&acc)[2][2][4][2], const Unit& u, int wr, int wc, int fr, int fq) const {
        const int pn = u.pn, seg = pn >> 1;
        const int row0 = u.pm * BM + wr * 64 + fr, ct0 = wc * 32 + 8 * fq;
        const bool ropelane = ((wc & 1) == 0) && (fq < 2);
        if (pn < 16) {
            bf16_t* dst = seg == 0 ? Q : seg == 1 ? Kb : seg == 2 ? V : seg == 3 ? QI : seg == 4 ? XR : seg == 5 ? GR : seg == 6 ? ZU : ZV;
            const bool dorope = (seg == 0 || seg == 1 || seg == 3) && ropelane;
            const bool dogelu = seg >= 5;
            const float sc = (seg == 0) ? 0.18033688011112042f : 1.f;
#pragma unroll
            for (int ai = 0; ai < 2; ++ai) {
                f32x4 csa[4], csb[4];
#pragma unroll
                for (int m = 0; m < 4; ++m) { csa[m] = (f32x4){1.f, 0.f, 1.f, 0.f}; csb[m] = csa[m];
                    if (dorope) { const float* rp = rope + (size_t)(row0 + ai * HALF + m * 16) * 16 + fq * 8; csa[m] = *(const f32x4*)rp; csb[m] = *(const f32x4*)(rp + 4); } }
#pragma unroll
                for (int m = 0; m < 4; ++m) { const int row = row0 + ai * HALF + m * 16;
                    const f32x4 cs0 = csa[m], cs1 = csb[m];
#pragma unroll
                    for (int bj = 0; bj < 2; ++bj) { const f32x4 v0 = acc[ai][bj][m][0], v1 = acc[ai][bj][m][1];
                        float v[8] = {v0[0], v0[1], v0[2], v0[3], v1[0], v1[1], v1[2], v1[3]};
                        if (dorope) { const float c[4] = {cs0[0], cs0[2], cs1[0], cs1[2]}, s[4] = {cs0[1], cs0[3], cs1[1], cs1[3]};
#pragma unroll
                            for (int i = 0; i < 4; ++i) { const float x1 = v[2 * i], x2 = v[2 * i + 1]; v[2 * i] = x1 * c[i] - x2 * s[i]; v[2 * i + 1] = x2 * c[i] + x1 * s[i]; } }
                        if (dogelu) {
#pragma unroll
                            for (int k = 0; k < 8; ++k) v[k] = gelu_tanh(v[k]); }
#pragma unroll
                        for (int k = 0; k < 8; ++k) v[k] *= sc;
                        *(u32x4*)(dst + (size_t)row * 512 + (pn & 1) * 256 + bj * HALF + ct0) = pack8(v); } } }
        } else {
#pragma unroll
            for (int ai = 0; ai < 2; ++ai)
#pragma unroll
                for (int m = 0; m < 4; ++m) { const int row = row0 + ai * HALF + m * 16;
                    const f32x4 v0 = acc[ai][0][m][0], v1 = acc[ai][0][m][1];
                    float v[8] = {v0[0], v0[1], v0[2], v0[3], v1[0], v1[1], v1[2], v1[3]};
                    if (wc < 2) {
                        if (wc == 0 && fq < 2) { const f32x4 cs0 = *(const f32x4*)(rope + (size_t)row * 16 + fq * 8), cs1 = *(const f32x4*)(rope + (size_t)row * 16 + fq * 8 + 4);
                            const float c[4] = {cs0[0], cs0[2], cs1[0], cs1[2]}, s[4] = {cs0[1], cs0[3], cs1[1], cs1[3]};
#pragma unroll
                            for (int i = 0; i < 4; ++i) { const float x1 = v[2 * i], x2 = v[2 * i + 1]; v[2 * i] = x1 * c[i] - x2 * s[i]; v[2 * i + 1] = x2 * c[i] + x1 * s[i]; } }
                        *(u32x4*)(KI + (size_t)row * 64 + ct0) = pack8(v);
                    } else if (wc == 2 && fq == 0) {
                        const float is = 0.04419417382415922f;
                        *(f32x4*)(WI + (size_t)row * 8) = (f32x4){v[0] * is, v[1] * is, v[2] * is, v[3] * is};
                        *(f32x4*)(WI + (size_t)row * 8 + 4) = (f32x4){v[4] * is, v[5] * is, v[6] * is, v[7] * is};
                    } }
        }
    }
};

struct EpiMerge {
    static constexpr bool PERM = true, AFTER_DRAIN = false, CHAIN = false;
    bf16_t* Mg; const bf16_t* G;
    __device__ __forceinline__ void operator()(const f32x4 (&acc)[2][2][4][2], const Unit& u, int wr, int wc, int fr, int fq) const {
        const int n = u.pm >> 7, pm = u.pm & 127, pn = u.pn & 3;
        const int row0 = pm * BM + wr * 64 + fr, col0 = pn * BM + wc * 32 + 8 * fq;
#pragma unroll
        for (int ai = 0; ai < 2; ++ai)
#pragma unroll
            for (int m = 0; m < 4; ++m) { const int row = row0 + ai * HALF + m * 16;
#pragma unroll
                for (int bj = 0; bj < 2; ++bj) { const int col = col0 + bj * HALF; const f32x4 v0 = acc[ai][bj][m][0], v1 = acc[ai][bj][m][1];
                    float v[8] = {v0[0], v0[1], v0[2], v0[3], v1[0], v1[1], v1[2], v1[3]}, g[8];
                    unpack8(*(const u32x4*)(G + (size_t)row * 3072 + n * 1024 + col), g);
#pragma unroll
                    for (int k = 0; k < 8; ++k) v[k] *= g[k];
                    bf16_t* op = Mg + (size_t)row * 1024 + col;
                    if (n > 0) { float o[8]; unpack8(*(const u32x4*)op, o);
#pragma unroll
                        for (int k = 0; k < 8; ++k) v[k] += o[k]; }
                    *(u32x4*)op = pack8(v); __builtin_amdgcn_sched_barrier(0); } }
    }
};
struct EpiMerge2 {
    static constexpr bool PERM = true, AFTER_DRAIN = false, CHAIN = true;
    bf16_t* Mg; const bf16_t* G;
    __device__ __forceinline__ bool keep(const Unit& u) const { return (u.pm >> 7) < 2; }
    __device__ __forceinline__ void operator()(f32x4 (&acc)[2][2][4][2], const Unit& u, int wr, int wc, int fr, int fq) const {
        const int n = u.pm >> 7, pm = u.pm & 127, pn = u.pn & 3;
        const int row0 = pm * BM + wr * 64 + fr, col0 = pn * BM + wc * 32 + 8 * fq;
#pragma unroll
        for (int ai = 0; ai < 2; ++ai)
#pragma unroll
            for (int mp = 0; mp < 2; ++mp) {
                u32x4 ga[2][2], gb[2][2];
#pragma unroll
                for (int mm = 0; mm < 2; ++mm)
#pragma unroll
                    for (int bj = 0; bj < 2; ++bj) { const bf16_t* gp = G + (size_t)(row0 + ai * HALF + (2 * mp + mm) * 16) * 3072 + col0 + bj * HALF;
                        ga[mm][bj] = *(const u32x4*)(gp + n * 1024); gb[mm][bj] = n < 2 ? *(const u32x4*)(gp + (n + 1) * 1024) : ga[mm][bj]; }
#pragma unroll
                for (int mm = 0; mm < 2; ++mm)
#pragma unroll
                    for (int bj = 0; bj < 2; ++bj) { const int m = 2 * mp + mm; float g[8]; unpack8(ga[mm][bj], g);
                        if (n < 2) { float h[8]; unpack8(gb[mm][bj], h);
#pragma unroll
                            for (int k = 0; k < 8; ++k) g[k] *= __builtin_amdgcn_rcpf(h[k]);
                            acc[ai][bj][m][0] *= (f32x4){g[0], g[1], g[2], g[3]}; acc[ai][bj][m][1] *= (f32x4){g[4], g[5], g[6], g[7]};
                        } else {
                            const f32x4 v0 = acc[ai][bj][m][0] * (f32x4){g[0], g[1], g[2], g[3]}, v1 = acc[ai][bj][m][1] * (f32x4){g[4], g[5], g[6], g[7]};
                            const float v[8] = {v0[0], v0[1], v0[2], v0[3], v1[0], v1[1], v1[2], v1[3]};
                            *(u32x4*)(Mg + (size_t)(row0 + ai * HALF + m * 16) * 1024 + col0 + bj * HALF) = pack8(v); } }
                __builtin_amdgcn_sched_barrier(0); }
    }
};
struct MergeOrder {
    StaticOrder so;
    __device__ bool next(int i, Unit& u) const { const int n = i % 3; Unit t; if (!so.next(i / 3, t)) return false; u.pm = n * 128 + t.pm; u.pn = n * 4 + t.pn; return true; }
    __device__ __forceinline__ void a_ready(const Unit&) const {}
    __device__ __forceinline__ void done(const Unit&) const {}
};

template <class Epi, class Sched, bool ALIGN_EPI = false, bool SP2 = false>
__device__ __forceinline__ void gemm_phase(PG8_LAS unsigned char* lds, const Gemm g, const Sched& S, const Epi& E, const int wave_id) {
    int tid_; asm volatile("v_mbcnt_lo_u32_b32 %0, -1, 0\n\tv_mbcnt_hi_u32_b32 %0, -1, %0" : "=v"(tid_)); tid_ += wave_id * 64; asm volatile("" : "+v"(tid_));
    const int tid = tid_, wid = __builtin_amdgcn_readfirstlane(tid >> 6), lane = tid & 63, wr = wid >> 2, wc = wid & 3, fr = lane & 15, fq = lane >> 4;
    const int K = g.K, nt = K / BK;
    unsigned voffA[2], voffB[2];
#pragma unroll
    for (int i = 0; i < 2; ++i) { int R, C; stage_rc(tid * 16 + i * 8192, R, C); const int Rb = Epi::PERM ? ((R & ~31) + perm32(R & 31)) : R;
        voffA[i] = (unsigned)(R * K + C) * 2u; voffB[i] = (unsigned)(Rb * K + C) * 2u; }
    const size_t kstep = (size_t)(BK * 2);
    const size_t hstep = (size_t)HALF * K * 2;
    const size_t tstep = 2 * hstep;
    const unsigned ldsw = (unsigned)wid * 1024u;
    const int aoff = lds_byte(wr * 64 + fr, fq * 8), boff = lds_byte(wc * 32 + fr, fq * 8);
#define PG8_SA(b, h) (((b) * 2 + (h)) * HTB)
#define PG8_SB(b, h) ((4 + (b) * 2 + (h)) * HTB)
#define PG8_STAGE(bufoff, gbase, voff) do { _Pragma("unroll") for (int _i = 0; _i < 2; ++_i) \
        __builtin_amdgcn_global_load_lds((const unsigned*)((const char*)(gbase) + (voff)[_i]), (PG8_LAS unsigned*)(lds + (bufoff) + ldsw + _i * 8192), 16, 0, 0); } while (0)
#define PG8_LDA(dst, b, h) do { _Pragma("unroll") for (int m = 0; m < 4; ++m) _Pragma("unroll") for (int k = 0; k < 2; ++k) dst[m][k] = *(const PG8_LAS bf16x8*)(lds + PG8_SA(b, h) + aoff + m * 2048 + k * 1024); } while (0)
#define PG8_LDB(dst, b, h) do { _Pragma("unroll") for (int n = 0; n < 2; ++n) _Pragma("unroll") for (int k = 0; k < 2; ++k) dst[n][k] = *(const PG8_LAS bf16x8*)(lds + PG8_SB(b, h) + boff + n * 2048 + k * 1024); } while (0)
#define PG8_MMA(ai, bj, At, Bt) do { __builtin_amdgcn_s_setprio(1); _Pragma("unroll") for (int m = 0; m < 4; ++m) _Pragma("unroll") for (int n = 0; n < 2; ++n) _Pragma("unroll") for (int k = 0; k < 2; ++k) \
        acc[ai][bj][m][n] = __builtin_amdgcn_mfma_f32_16x16x32_bf16(Bt[n][k], At[m][k], acc[ai][bj][m][n], 0, 0, 0); __builtin_amdgcn_s_setprio(0); } while (0)
#define PG8_WAIT_V(n) asm volatile("s_waitcnt vmcnt(" #n ")" ::: "memory")
#define PG8_WAIT_L(n) asm volatile("s_waitcnt lgkmcnt(" #n ")" ::: "memory")
#define PG8_BAR __builtin_amdgcn_s_barrier()
#define PG8_SCHED __builtin_amdgcn_sched_barrier(0)
    Unit cur, nxt; int ui = 0;
    if (!S.next(0, cur)) return;
    f32x4 acc[2][2][4][2];
#pragma unroll
    for (int a = 0; a < 2; ++a)
#pragma unroll
        for (int b = 0; b < 2; ++b)
#pragma unroll
            for (int m = 0; m < 4; ++m)
#pragma unroll
                for (int n = 0; n < 2; ++n) acc[a][b][m][n] = (f32x4){0.f, 0.f, 0.f, 0.f};
    bf16x8 At[4][2], B0[2][2], B1[2][2];
    const char* cA = (const char*)g.A + (size_t)cur.pm * tstep; const char* cB = (const char*)g.Bt + (size_t)cur.pn * tstep;
    S.a_ready(cur);
    if constexpr (SP2) {
        PG8_STAGE(PG8_SB(0, 0), cB, voffB); PG8_STAGE(PG8_SB(0, 1), cB + hstep, voffB); PG8_STAGE(PG8_SA(0, 0), cA, voffA); PG8_STAGE(PG8_SA(0, 1), cA + hstep, voffA);
        if (wr == 1) PG8_BAR;
        PG8_WAIT_V(2); PG8_BAR;
        PG8_STAGE(PG8_SB(1, 0), cB + kstep, voffB); PG8_STAGE(PG8_SA(1, 0), cA + kstep, voffA); PG8_STAGE(PG8_SB(1, 1), cB + hstep + kstep, voffB);
        PG8_WAIT_V(6); PG8_BAR;
    } else {
        PG8_STAGE(PG8_SB(0, 0), cB, voffB); PG8_STAGE(PG8_SA(0, 0), cA, voffA); PG8_STAGE(PG8_SB(0, 1), cB + hstep, voffB); PG8_STAGE(PG8_SA(0, 1), cA + hstep, voffA);
        if (wr == 1) PG8_BAR;
        PG8_WAIT_V(4); PG8_BAR;
        PG8_STAGE(PG8_SB(1, 0), cB + kstep, voffB); PG8_STAGE(PG8_SA(1, 0), cA + kstep, voffA); PG8_STAGE(PG8_SB(1, 1), cB + hstep + kstep, voffB);
        PG8_WAIT_V(6); PG8_BAR;
    }
    for (;;) {
        const bool has_next = S.next(ui + 1, nxt);
        const char* nA = has_next ? (const char*)g.A + (size_t)nxt.pm * tstep : cA; const char* nB = has_next ? (const char*)g.Bt + (size_t)nxt.pn * tstep : cB;
        for (int t = 0; t < nt; t += 2) {
            const bool last = (t == nt - 2);
            const char* a1 = cA + (size_t)(t + 1) * kstep;
            const char* a2 = last ? nA : cA + (size_t)(t + 2) * kstep; const char* b2 = last ? nB : cB + (size_t)(t + 2) * kstep;
            const char* a3 = a2 + kstep; const char* b3 = b2 + kstep;
            if (last && has_next) S.a_ready(nxt);
            if constexpr (SP2) {
            PG8_LDB(B0, 0, 0); PG8_LDB(B1, 0, 1); PG8_SCHED; PG8_LDA(At, 0, 0); PG8_STAGE(PG8_SA(1, 1), a1 + hstep, voffA);
            PG8_WAIT_V(8); PG8_WAIT_L(0); PG8_BAR; PG8_MMA(0, 0, At, B0); PG8_MMA(0, 1, At, B1); PG8_BAR; PG8_SCHED;
            PG8_LDA(At, 0, 1); PG8_STAGE(PG8_SB(0, 0), b2, voffB); PG8_STAGE(PG8_SB(0, 1), b2 + hstep, voffB); PG8_STAGE(PG8_SA(0, 0), a2, voffA);
            PG8_WAIT_V(8); PG8_WAIT_L(0); PG8_BAR; PG8_MMA(1, 0, At, B0); PG8_MMA(1, 1, At, B1); PG8_BAR; PG8_SCHED;
            PG8_LDB(B0, 1, 0); PG8_LDB(B1, 1, 1); PG8_SCHED; PG8_LDA(At, 1, 0); PG8_STAGE(PG8_SA(0, 1), a2 + hstep, voffA);
            PG8_WAIT_V(8); PG8_WAIT_L(0); PG8_BAR; PG8_MMA(0, 0, At, B0); PG8_MMA(0, 1, At, B1); PG8_BAR; PG8_SCHED;
            PG8_LDA(At, 1, 1); PG8_STAGE(PG8_SB(1, 0), b3, voffB); PG8_STAGE(PG8_SB(1, 1), b3 + hstep, voffB); PG8_STAGE(PG8_SA(1, 0), a3, voffA);
            PG8_WAIT_V(8); PG8_WAIT_L(0); PG8_BAR; PG8_MMA(1, 0, At, B0); PG8_MMA(1, 1, At, B1); PG8_BAR; PG8_SCHED;
            } else {
            PG8_LDB(B0, 0, 0); PG8_SCHED; PG8_LDA(At, 0, 0); PG8_STAGE(PG8_SA(1, 1), a1 + hstep, voffA);
            PG8_WAIT_L(8); PG8_BAR; PG8_WAIT_L(0); PG8_MMA(0, 0, At, B0); PG8_BAR; PG8_SCHED;
            PG8_LDB(B1, 0, 1); PG8_STAGE(PG8_SB(0, 0), b2, voffB);
            PG8_BAR; PG8_WAIT_L(0); PG8_MMA(0, 1, At, B1); PG8_BAR;
            PG8_LDA(At, 0, 1); PG8_STAGE(PG8_SA(0, 0), a2, voffA);
            PG8_BAR; PG8_WAIT_L(0); PG8_MMA(1, 0, At, B0); PG8_BAR; PG8_SCHED;
            PG8_STAGE(PG8_SB(0, 1), b2 + hstep, voffB);
            PG8_WAIT_V(6); PG8_BAR; PG8_MMA(1, 1, At, B1); PG8_BAR;
            PG8_LDB(B0, 1, 0); PG8_SCHED; PG8_LDA(At, 1, 0); PG8_STAGE(PG8_SA(0, 1), a2 + hstep, voffA);
            PG8_WAIT_L(8); PG8_BAR; PG8_WAIT_L(0); PG8_MMA(0, 0, At, B0); PG8_BAR; PG8_SCHED;
            PG8_LDB(B1, 1, 1); PG8_STAGE(PG8_SB(1, 0), b3, voffB);
            PG8_BAR; PG8_WAIT_L(0); PG8_MMA(0, 1, At, B1); PG8_BAR;
            PG8_LDA(At, 1, 1); PG8_STAGE(PG8_SA(1, 0), a3, voffA);
            PG8_BAR; PG8_WAIT_L(0); PG8_MMA(1, 0, At, B0); PG8_BAR; PG8_SCHED;
            PG8_STAGE(PG8_SB(1, 1), b3 + hstep, voffB);
            PG8_WAIT_V(6); PG8_BAR; PG8_MMA(1, 1, At, B1); PG8_BAR;
            }
        }
        if constexpr (ALIGN_EPI) { if (wr == 0) PG8_BAR; }
        if constexpr (!Epi::AFTER_DRAIN) { int l_; asm volatile("v_mbcnt_lo_u32_b32 %0, -1, 0\n\tv_mbcnt_hi_u32_b32 %0, -1, %0" : "=v"(l_)); E(acc, cur, wr, wc, l_ & 15, l_ >> 4); S.done(cur); }
        if (!has_next) break;
        bool keep_ = false; if constexpr (Epi::CHAIN) keep_ = E.keep(cur);
        if (!keep_) {
#pragma unroll
        for (int a = 0; a < 2; ++a)
#pragma unroll
            for (int b = 0; b < 2; ++b)
#pragma unroll
                for (int m = 0; m < 4; ++m)
#pragma unroll
                    for (int n = 0; n < 2; ++n) acc[a][b][m][n] = (f32x4){0.f, 0.f, 0.f, 0.f};
        }
        cur = nxt; cA = nA; cB = nB; ++ui;
        if constexpr (ALIGN_EPI) { if (wr == 1) PG8_BAR; }
    }
    PG8_WAIT_V(0);
    if constexpr (!ALIGN_EPI) { if (wr == 0) PG8_BAR; }
    PG8_BAR;
    if constexpr (Epi::AFTER_DRAIN) { E.fused(acc, cur, wr, wc, fr, fq, lds, wid, lane); S.done(cur); }
#undef PG8_SA
#undef PG8_SB
#undef PG8_STAGE
#undef PG8_LDA
#undef PG8_LDB
#undef PG8_MMA
#undef PG8_WAIT_V
#undef PG8_WAIT_L
#undef PG8_BAR
#undef PG8_SCHED
}
}

constexpr int NWAVES = 8;
#ifndef MK_ONE_LAUNCH
#define MK_ONE_LAUNCH 1
#endif
#ifndef REP_G
#define REP_G 1
#endif
#ifndef REP_A
#define REP_A 1
#endif
#ifndef REP_M
#define REP_M 1
#endif
#ifndef REP_I
#define REP_I 1
#endif
#ifndef REP_P3
#define REP_P3 1
#endif
#ifndef REP_N
#define REP_N 1
#endif
#ifndef REP_MG
#define REP_MG 1
#endif
#ifndef REP_PRO
#define REP_PRO 1
#endif
constexpr int NB = 8, SEQ = 4096, D = 1024, M = NB * SEQ, NLAYER = 2;
constexpr int INW = 7240, NA = 17 * 256, NG = 3072, NIN = NA + NG, FF = 4096, PLE = 256;
constexpr float EPS = 1e-6f;
constexpr int PH_PER_LAYER = 13, NPH = 1 + NLAYER * PH_PER_LAYER;
constexpr size_t MiB = 1u << 20;
constexpr size_t WS_CTL = 0, CTL_ZERO_BYTES = 1 * MiB;
constexpr size_t WS_ROPE = 1 * MiB;
constexpr size_t WS_AGG = 3 * MiB;
constexpr size_t WS_W = 4 * MiB, W_LAYER = 38 * MiB;
constexpr size_t WO_IN = 0, WO_BR = WO_IN + (size_t)NIN * D * 2, WO_OUT = WO_BR + 3 * MiB, WO_UP = WO_OUT + 2 * MiB, WO_DN = WO_UP + 8 * MiB, WO_PLE = WO_DN + 8 * MiB, WO_PG = WO_PLE + MiB / 2;
static_assert(WO_PG + 2 * MiB == W_LAYER, "weight map");
constexpr size_t WS_P = 80 * MiB;
constexpr size_t WS_H = 112 * MiB;
constexpr size_t WS_Q = 176 * MiB, WS_K = 208 * MiB, WS_V = 240 * MiB, WS_XR = 272 * MiB, WS_GR = 304 * MiB, WS_ZV = 336 * MiB;
constexpr size_t WS_G = 176 * MiB;
constexpr size_t WS_QI = 368 * MiB, WS_ZU = 400 * MiB, WS_YC = 432 * MiB;
constexpr size_t WS_KI = 464 * MiB, WS_WI = 468 * MiB, WS_SEL = 469 * MiB;
constexpr size_t WS_T = 176 * MiB;
constexpr size_t WS_U = 176 * MiB;
constexpr size_t WS_T2 = 432 * MiB;
constexpr size_t WS_S = 176 * MiB, WS_T3 = 240 * MiB;
constexpr size_t WS_XPARK = 304 * MiB;
constexpr size_t WS_END = 496 * MiB;
constexpr int CW_BAR = 4096;
constexpr int LDS_BYTES = 155648;
constexpr int MISC_OFF = 147456 + 320;

#define GAS __attribute__((address_space(1)))
#define LAS __attribute__((address_space(3)))
typedef unsigned short bf16;
typedef unsigned v4u __attribute__((ext_vector_type(4)));
typedef unsigned v2u __attribute__((ext_vector_type(2)));
typedef float f32x4 __attribute__((ext_vector_type(4)));
typedef float f32x2 __attribute__((ext_vector_type(2)));
typedef GAS unsigned gu32;
#define RLX_AGENT __ATOMIC_RELAXED, __HIP_MEMORY_SCOPE_AGENT
#define LDS_WAIT() asm volatile("s_waitcnt lgkmcnt(0)" ::: "memory")
#define VM_WAIT() asm volatile("s_waitcnt vmcnt(0)" ::: "memory")
using pg8::bflo; using pg8::bfhi; using pg8::unpack8; using pg8::pack8; using pg8::sigm;
__device__ __forceinline__ float bf2f(bf16 b) { return __builtin_bit_cast(float, (unsigned)b << 16); }
__device__ __forceinline__ unsigned f2bf(float f) { unsigned u = __builtin_bit_cast(unsigned, f); return (u + 0x7fffu + ((u >> 16) & 1u)) >> 16; }
__device__ __forceinline__ unsigned pk2(float lo, float hi) { return f2bf(lo) | (f2bf(hi) << 16); }

__device__ __forceinline__ int lane_id() { int l; asm volatile("v_mbcnt_lo_u32_b32 %0, -1, 0\n\tv_mbcnt_hi_u32_b32 %0, -1, %0" : "=v"(l)); return l; }
#define XB_TMO      128
#define XB_XCNT(j)  (256  + 64 * (j))
#define XB_XSUB(j)  (1280 + 64 * (j))
#define XB_XGEN(j)  (2304 + 64 * (j))
#define XB_TOP      3328
#define XB_TOPGEN   3392
#define XCD_BAR_WORDS 3456
#define XB_SPIN_CAP (1u << 18)

__device__ __forceinline__ unsigned xb_ld(unsigned* p)              { return __hip_atomic_load(p, __ATOMIC_RELAXED, __HIP_MEMORY_SCOPE_AGENT); }
__device__ __forceinline__ unsigned xb_add(unsigned* p, unsigned v) { return __hip_atomic_fetch_add(p, v, __ATOMIC_RELAXED, __HIP_MEMORY_SCOPE_AGENT); }
__device__ __forceinline__ unsigned xb_xcc_id() { return (unsigned)__builtin_amdgcn_s_getreg((3 << 11) | 20) & 0xFu; }
#define XB_SPIN(cond, bar) do { unsigned _sp = 0; while (cond) { __builtin_amdgcn_s_sleep(1); \
    if ((++_sp & 255u) == 0u) { if (xb_ld(&(bar)[XB_TMO])) break; if (_sp > XB_SPIN_CAP) { atomicAdd(&(bar)[XB_TMO], 1u); break; } } } } while (0)

struct XcdBarrier {
    unsigned* bar; unsigned x;
    volatile LAS unsigned* st;
    int w0;
};

__device__ __forceinline__ XcdBarrier xcd_barrier_post(unsigned* bar, volatile LAS unsigned* st, int w0) {
    XcdBarrier b; b.bar = bar; b.x = xb_xcc_id(); b.st = st; b.w0 = w0;
    if (w0 == 0 && lane_id() == 0) (void)xb_add(&bar[XB_XCNT(b.x)], 1u);
    return b;
}
__device__ __forceinline__ void xcd_barrier_complete(unsigned* bar, unsigned x, unsigned& nloc, unsigned& nx) {
    const unsigned G = gridDim.x * gridDim.y * gridDim.z;
    unsigned sum, cnt, mine, sp = 0u;
    for (;;) {
        sum = 0u; cnt = 0u; mine = 0u;
#pragma unroll
        for (unsigned j = 0; j < 16; ++j) { const unsigned c = xb_ld(&bar[XB_XCNT(j)]); sum += c; cnt += (c > 0u) ? 1u : 0u; mine = (j == x) ? c : mine; }
        if (sum == G) break;
        __builtin_amdgcn_s_sleep(1);
        if ((++sp & 255u) == 0u) { if (xb_ld(&bar[XB_TMO])) break; if (sp > XB_SPIN_CAP) { atomicAdd(&bar[XB_TMO], 1u); break; } }
    }
    nloc = mine > 0u ? mine : 1u; nx = cnt > 0u ? cnt : 1u;
}

__device__ __forceinline__ void xcd_barrier(const XcdBarrier& b) {
    asm volatile("s_waitcnt vmcnt(0)" ::: "memory");
    __syncthreads();
    if (b.w0 == 0 && lane_id() == 0) {
        unsigned* bar = b.bar;
        __builtin_amdgcn_s_waitcnt(0);
        unsigned nloc = b.st[0], nx = b.st[1];
        if (nloc == 0u) { xcd_barrier_complete(bar, b.x, nloc, nx); b.st[0] = nloc; b.st[1] = nx; }
        const unsigned old = xb_add(&bar[XB_XSUB(b.x)], 1u);
        const unsigned gen = old / nloc;
        if (old + 1u == (gen + 1u) * nloc) {
            __builtin_amdgcn_fence(__ATOMIC_RELEASE, "agent");
            asm volatile("s_waitcnt vmcnt(0)" ::: "memory");
            const unsigned og = xb_add(&bar[XB_TOP], 1u);
            const unsigned tg = og / nx;
            if (og + 1u == (tg + 1u) * nx) xb_add(&bar[XB_TOPGEN], 1u);
            else XB_SPIN(xb_ld(&bar[XB_TOPGEN]) == tg, bar);
            __builtin_amdgcn_fence(__ATOMIC_ACQUIRE, "agent");
            xb_add(&bar[XB_XGEN(b.x)], 1u);
            asm volatile("s_waitcnt vmcnt(0)" ::: "memory");
        } else {
            XB_SPIN(xb_ld(&bar[XB_XGEN(b.x)]) == gen, bar);
            __builtin_amdgcn_fence(__ATOMIC_ACQUIRE, "agent");
            asm volatile("s_waitcnt vmcnt(0)" ::: "memory");
        }
    }
    __syncthreads();
}


__device__ __forceinline__ float wave_sum(float v) {
#pragma unroll
    for (int o = 1; o < 64; o <<= 1) v += __shfl_xor(v, o);
    return v;
}
__device__ __forceinline__ float wave_max(float v) {
#pragma unroll
    for (int o = 1; o < 64; o <<= 1) v = fmaxf(v, __shfl_xor(v, o));
    return v;
}
__device__ __forceinline__ int prefix_popc(unsigned long long m) { return (int)__builtin_amdgcn_mbcnt_hi((unsigned)(m >> 32), __builtin_amdgcn_mbcnt_lo((unsigned)m, 0u)); }

__device__ __forceinline__ void zero_rows(bf16* Y, int blk, int G, int tid) { for (size_t e = (size_t)(blk * 512 + tid) * 8; e < (size_t)M * 512; e += (size_t)G * 512 * 8) *(GAS v4u*)(Y + e) = (v4u){0u, 0u, 0u, 0u}; }
template <class Map>
__device__ __forceinline__ void transpose_item(const float* W, int K, int Nsrc, bf16* WT, int nblk, LAS float* scr, int item, int lane, Map map) {
    const int kb = item / nblk, nb = item % nblk, k0 = 64 * kb, d0 = 32 * nb;
    const int sb = map.base(d0), cnt = map.count(d0); const bool il = map.interleave(d0);
    const int c4 = (lane & 7) * 4, kr = lane >> 3;
    int dp[4];
#pragma unroll
    for (int e = 0; e < 4; ++e) { const int c = c4 + e; dp[e] = (il && c < 16) ? 2 * (c & 7) + (c >> 3) : c; }
#pragma unroll
    for (int i = 0; i < 8; ++i) { const int kk = 8 * i + kr;
        const f32x4 v = c4 < cnt ? *(const GAS f32x4*)(W + (size_t)(k0 + kk) * Nsrc + sb + c4) : (f32x4){0.f, 0.f, 0.f, 0.f};
        scr[kk * 33 + dp[0]] = v[0]; scr[kk * 33 + dp[1]] = v[1]; scr[kk * 33 + dp[2]] = v[2]; scr[kk * 33 + dp[3]] = v[3]; }
    LDS_WAIT();
    const int c = lane & 7;
#pragma unroll
    for (int j = 0; j < 4; ++j) { const int n = (lane >> 3) + 8 * j; const LAS float* s = scr + (8 * c) * 33 + n;
        v4u o; o.x = pk2(s[0 * 33], s[1 * 33]); o.y = pk2(s[2 * 33], s[3 * 33]); o.z = pk2(s[4 * 33], s[5 * 33]); o.w = pk2(s[6 * 33], s[7 * 33]);
        *(GAS v4u*)(WT + (size_t)(d0 + n) * K + k0 + 8 * c) = o; }
    LDS_WAIT();
}
struct MapIdent { int off; __device__ __forceinline__ int base(int d0) const { return off + d0; } __device__ __forceinline__ int count(int) const { return 32; } __device__ __forceinline__ bool interleave(int) const { return false; } };
struct MapIn {
    __device__ __forceinline__ int base(int d0) const {
        const int tile = d0 >> 8, r = d0 & 255;
        if (tile < 16) { const int seg = tile >> 1;
            const int sbs = seg == 0 ? 0 : seg == 1 ? 512 : seg == 2 ? 1024 : seg == 3 ? 1536 : seg == 4 ? 2120 : seg == 5 ? 2632 : seg == 6 ? 3144 : 3656;
            return sbs + (tile & 1) * 256 + r; }
        if (tile == 16) return r < 64 ? 2048 + r : 2112;
        return 4168 + (d0 - NA);
    }
    __device__ __forceinline__ int count(int d0) const { const int tile = d0 >> 8, r = d0 & 255; return tile != 16 ? 32 : r < 64 ? 32 : r == 64 ? 8 : 0; }
    __device__ __forceinline__ bool interleave(int d0) const { const int tile = d0 >> 8, r = d0 & 255, seg = tile >> 1;
        return ((tile < 16 && (seg == 0 || seg == 1 || seg == 3)) || tile == 16) && (r & 63) == 0 && (tile != 16 || r == 0); }
};
__device__ __forceinline__ void sincos_d(float af, float& s, float& c) {
    const double a = (double)af;
    const double k = __builtin_rint(a * 0.63661977236758134308);
    double r = __builtin_fma(-k, 1.57079632679489655800e+00, a); r = __builtin_fma(-k, 6.12323399573676603587e-17, r);
    const double r2 = r * r;
    double sp = -7.6471637318198164759e-13; sp = sp * r2 + 1.6059043836821614599e-10; sp = sp * r2 - 2.5052108385441718775e-08; sp = sp * r2 + 2.7557319223985890653e-06; sp = sp * r2 - 1.9841269841269841270e-04; sp = sp * r2 + 8.3333333333333333333e-03; sp = sp * r2 - 1.6666666666666666667e-01;
    const double sn = r + r * r2 * sp;
    double cp = 4.7794773323873852974e-14; cp = cp * r2 - 1.1470745597729724714e-11; cp = cp * r2 + 2.0876756987868098979e-09; cp = cp * r2 - 2.7557319223985890653e-07; cp = cp * r2 + 2.4801587301587301587e-05; cp = cp * r2 - 1.3888888888888888889e-03; cp = cp * r2 + 4.1666666666666666667e-02; cp = cp * r2 - 0.5;
    const double cn = 1.0 + r2 * cp;
    const int q = (int)((long long)k & 3);
    const double ss = (q == 0) ? sn : (q == 1) ? cn : (q == 2) ? -sn : -cn;
    const double cc = (q == 0) ? cn : (q == 1) ? -sn : (q == 2) ? -cn : sn;
    s = (float)ss; c = (float)cc;
}

struct Args { const float* in[25]; float* out; unsigned char* ws; int ph_lo, ph_hi; };
typedef __attribute__((address_space(4))) const unsigned char* kptr_t;
__device__ __forceinline__ kptr_t kbase() { kptr_t k = (kptr_t)__builtin_amdgcn_kernarg_segment_ptr(); asm volatile("" : "+s"(k)); return k; }
__device__ __forceinline__ const float* kin(int i) { return *(const float* const __attribute__((address_space(4)))*)(kbase() + 8 * i); }
__device__ __forceinline__ float* kout() { return *(float* const __attribute__((address_space(4)))*)(kbase() + 200); }
__device__ __forceinline__ unsigned char* kws() { return *(unsigned char* const __attribute__((address_space(4)))*)(kbase() + 208); }
static_assert(sizeof(Args) == 224, "Args layout");

typedef _Float16 f16x4 __attribute__((ext_vector_type(4)));
template <class TI> __device__ __forceinline__ f32x4 ld_x4(const TI* p);
template <> __device__ __forceinline__ f32x4 ld_x4<float>(const float* p) { return *(const GAS f32x4*)p; }
template <> __device__ __forceinline__ f32x4 ld_x4<_Float16>(const _Float16* p) { const f16x4 h = *(const GAS f16x4*)p; return (f32x4){(float)h[0], (float)h[1], (float)h[2], (float)h[3]}; }
__device__ __forceinline__ void st_x4(float* p, f32x4 v) { *(GAS f32x4*)p = v; }
__device__ __forceinline__ void st_x4(_Float16* p, f32x4 v) { *(GAS f16x4*)p = (f16x4){(_Float16)v[0], (_Float16)v[1], (_Float16)v[2], (_Float16)v[3]}; }
template <class TI, class TO>
__device__ __forceinline__ void norm_phase(const TI* xin, TO* xout, const bf16* T, const float* gpost, const float* gnext, bf16* O, int mode, int gw, int NGW, int lane, float tscale = 1.f) {
    constexpr int R = 2;
    for (int row0 = gw; row0 < M; row0 += R * NGW) {
        f32x4 x[R][4], t[R][4];
#pragma unroll
        for (int rr = 0; rr < R; ++rr) { const size_t row = (size_t)(row0 + rr * NGW);
#pragma unroll
            for (int j = 0; j < 4; ++j) x[rr][j] = ld_x4<TI>(xin + row * D + j * 256 + lane * 4);
            if (T) {
#pragma unroll
                for (int j = 0; j < 4; ++j) { const v2u w = *(const GAS v2u*)(T + row * D + j * 256 + lane * 4); t[rr][j] = (f32x4){bflo(w.x), bfhi(w.x), bflo(w.y), bfhi(w.y)}; } }
        }
#pragma unroll
        for (int rr = 0; rr < R; ++rr) { const size_t row = (size_t)(row0 + rr * NGW);
            if (T) {
                float ss = 0.f;
#pragma unroll
                for (int j = 0; j < 4; ++j) ss += (t[rr][j][0] * t[rr][j][0] + t[rr][j][1] * t[rr][j][1]) + (t[rr][j][2] * t[rr][j][2] + t[rr][j][3] * t[rr][j][3]);
                const float r = 1.f / sqrtf(wave_sum(ss) * (1.f / D) + EPS);
#pragma unroll
                for (int j = 0; j < 4; ++j) { const f32x4 g = *(const GAS f32x4*)(gpost + j * 256 + lane * 4); x[rr][j] += t[rr][j] * (r * tscale) * g; }
            }
            if (xout) {
#pragma unroll
                for (int j = 0; j < 4; ++j) st_x4(xout + row * D + j * 256 + lane * 4, x[rr][j]); }
            if (mode == 0) {
                float ss = 0.f;
#pragma unroll
                for (int j = 0; j < 4; ++j) ss += (x[rr][j][0] * x[rr][j][0] + x[rr][j][1] * x[rr][j][1]) + (x[rr][j][2] * x[rr][j][2] + x[rr][j][3] * x[rr][j][3]);
                const float r = 1.f / sqrtf(wave_sum(ss) * (1.f / D) + EPS);
#pragma unroll
                for (int j = 0; j < 4; ++j) { const f32x4 g = *(const GAS f32x4*)(gnext + j * 256 + lane * 4); const f32x4 o = x[rr][j] * r * g;
                    *(GAS v2u*)(O + row * D + j * 256 + lane * 4) = (v2u){pg8::cvt_pk_bf16(o[0], o[1]), pg8::cvt_pk_bf16(o[2], o[3])}; }
            } else if (mode == 1) {
#pragma unroll
                for (int j = 0; j < 4; ++j) *(GAS v2u*)(O + row * D + j * 256 + lane * 4) = (v2u){pg8::cvt_pk_bf16(x[rr][j][0], x[rr][j][1]), pg8::cvt_pk_bf16(x[rr][j][2], x[rr][j][3])};
            }
        }
    }
}

typedef float f32x16 __attribute__((ext_vector_type(16)));
typedef short bf16x8v __attribute__((ext_vector_type(8)));
#define MFMA32(a, b, c) __builtin_amdgcn_mfma_f32_32x32x16_bf16((a), (b), (c), 0, 0, 0)
__device__ __forceinline__ bf16x8v pack_frag(float a0, float a1, float a2, float a3, float a4, float a5, float a6, float a7) {
    v4u w; w.x = pg8::cvt_pk_bf16(a0, a1); w.y = pg8::cvt_pk_bf16(a2, a3); w.z = pg8::cvt_pk_bf16(a4, a5); w.w = pg8::cvt_pk_bf16(a6, a7); return __builtin_bit_cast(bf16x8v, w); }
__device__ __forceinline__ float and_bits(float x, int m) { return __builtin_bit_cast(float, __builtin_bit_cast(int, x) & m); }
constexpr int AT_P = 144, AT_BUF = 64 * AT_P, AT_VOFF = 2 * AT_BUF;
template <bool SAFE>
__device__ __forceinline__ bool attn_unit(LAS unsigned char* lds, const bf16* Q, const bf16* K, const bf16* V, const unsigned* MASK, bf16* YA, int b, int h, int qb, int tid, int wave, int lane) {
    const int r = lane & 31, hi = lane >> 5;
    const int skey = tid >> 3, sch = tid & 7;
    const int spos = (skey & 0x33) | ((skey & 4) << 1) | ((skey & 8) >> 1);
    LAS unsigned char* kw = lds + skey * AT_P + sch * 16;
    LAS unsigned char* vw = lds + AT_VOFF + (sch * 8) * AT_P + spos * 2;
    LAS unsigned* flag = (LAS unsigned*)(lds + AT_VOFF + 2 * AT_BUF);
    const int ntile = 4 * (qb + 1);
    const size_t rowbase = (size_t)b * SEQ;
    const int q = qb * 256 + wave * 32 + r;
    bf16x8v qf[4];
#pragma unroll
    for (int ks = 0; ks < 4; ++ks) qf[ks] = *(const GAS bf16x8v*)(Q + (rowbase + q) * 512 + h * 64 + 16 * ks + 8 * hi);
    const GAS unsigned* mrow = (const GAS unsigned*)MASK + (rowbase + q) * 128;
    const bf16* kg = K + (rowbase + skey) * 512 + h * 64 + sch * 8;
    const bf16* vg = V + (rowbase + skey) * 512 + h * 64 + sch * 8;
    float m = SAFE ? -1e30f : 0.f;
    f32x16 o0, o1, o2;
#pragma unroll
    for (int i = 0; i < 16; ++i) { o0[i] = 0.f; o1[i] = 0.f; o2[i] = 0.f; }
    const unsigned one2 = r == 0 ? 0x3F803F80u : 0u;
    const bf16x8v onesf = __builtin_bit_cast(bf16x8v, (v4u){one2, one2, one2, one2});
    v4u kreg = *(const GAS v4u*)kg, vreg = *(const GAS v4u*)vg;
    v2u mw = *(const GAS v2u*)mrow;
    __syncthreads();
    if (tid == 0) flag[0] = 0u;
    *(LAS v4u*)kw = kreg;
    { const unsigned vv[4] = {vreg.x, vreg.y, vreg.z, vreg.w};
#pragma unroll
      for (int i = 0; i < 8; ++i) *(LAS unsigned short*)(vw + i * AT_P) = (unsigned short)(vv[i >> 1] >> (16 * (i & 1))); }
    __syncthreads();
#pragma unroll 1
    for (int it = 0; it < ntile; ++it) {
        const int cur = it & 1; const bool more = it + 1 < ntile;
        v4u kn = kreg, vn = vreg; v2u mwn = mw;
        if (more) { kn = *(const GAS v4u*)(kg + (size_t)(it + 1) * 64 * 512); vn = *(const GAS v4u*)(vg + (size_t)(it + 1) * 64 * 512); mwn = *(const GAS v2u*)(mrow + (it + 1) * 2); }
        const LAS unsigned char* kb = lds + cur * AT_BUF;
        const LAS unsigned char* vb = lds + AT_VOFF + cur * AT_BUF;
        f32x16 s0, s1;
#pragma unroll
        for (int i = 0; i < 16; ++i) { s0[i] = 0.f; s1[i] = 0.f; }
#pragma unroll
        for (int ks = 0; ks < 4; ++ks) {
            const bf16x8v a0 = *(const LAS bf16x8v*)(kb + r * AT_P + (16 * ks + 8 * hi) * 2), a1 = *(const LAS bf16x8v*)(kb + (32 + r) * AT_P + (16 * ks + 8 * hi) * 2);
            s0 = MFMA32(a0, qf[ks], s0); s1 = MFMA32(a1, qf[ks], s1); }
        const int w0 = (int)(mw.x >> (4 * hi)), w1 = (int)(mw.y >> (4 * hi));
        float mn = 0.f;
        if (SAFE) {
            float mx = fmaxf(s0[0], s1[0]);
#pragma unroll
            for (int i = 1; i < 16; ++i) mx = fmaxf(mx, fmaxf(s0[i], s1[i]));
            mx = fmaxf(mx, __shfl_xor(mx, 32));
            mn = fmaxf(m, mx);
            if (__any(mn != m)) {
                const float alpha = __builtin_amdgcn_exp2f(m - mn); m = mn;
#pragma unroll
                for (int i = 0; i < 16; ++i) { o0[i] *= alpha; o1[i] *= alpha; }
                o2[0] *= alpha;
            }
        }
#pragma unroll
        for (int i = 0; i < 16; ++i) { const int p = 8 * (i >> 2) + (i & 3);
            s0[i] = and_bits(__builtin_amdgcn_exp2f(SAFE ? s0[i] - mn : s0[i]), __builtin_amdgcn_sbfe(w0, p, 1)); s1[i] = and_bits(__builtin_amdgcn_exp2f(SAFE ? s1[i] - mn : s1[i]), __builtin_amdgcn_sbfe(w1, p, 1)); }
        const bf16x8v p00 = pack_frag(s0[0], s0[1], s0[2], s0[3], s0[4], s0[5], s0[6], s0[7]), p01 = pack_frag(s0[8], s0[9], s0[10], s0[11], s0[12], s0[13], s0[14], s0[15]);
        const bf16x8v p10 = pack_frag(s1[0], s1[1], s1[2], s1[3], s1[4], s1[5], s1[6], s1[7]), p11 = pack_frag(s1[8], s1[9], s1[10], s1[11], s1[12], s1[13], s1[14], s1[15]);
        o2 = MFMA32(onesf, p00, o2); o2 = MFMA32(onesf, p01, o2); o2 = MFMA32(onesf, p10, o2); o2 = MFMA32(onesf, p11, o2);
#define AT_VF(dt, st, s) (*(const LAS bf16x8v*)(vb + (32 * (dt) + r) * AT_P + ((((st) << 5) | ((s) << 4)) + 8 * hi) * 2))
        o0 = MFMA32(AT_VF(0, 0, 0), p00, o0); o0 = MFMA32(AT_VF(0, 0, 1), p01, o0); o0 = MFMA32(AT_VF(0, 1, 0), p10, o0); o0 = MFMA32(AT_VF(0, 1, 1), p11, o0);
        o1 = MFMA32(AT_VF(1, 0, 0), p00, o1); o1 = MFMA32(AT_VF(1, 0, 1), p01, o1); o1 = MFMA32(AT_VF(1, 1, 0), p10, o1); o1 = MFMA32(AT_VF(1, 1, 1), p11, o1);
#undef AT_VF
        if (more) {
            *(LAS v4u*)(kw + (cur ^ 1) * AT_BUF) = kn;
            const unsigned vv[4] = {vn.x, vn.y, vn.z, vn.w};
#pragma unroll
            for (int i = 0; i < 8; ++i) *(LAS unsigned short*)(vw + (cur ^ 1) * AT_BUF + i * AT_P) = (unsigned short)(vv[i >> 1] >> (16 * (i & 1)));
            mw = mwn;
        }
        __syncthreads();
    }
    const float l = __shfl(o2[0], r);
    const bool okl = l > 1e-30f && l < 1e30f;
    if (!SAFE) { if (__any(!okl) && lane == 0) flag[0] = 1u; }
    const float inv = okl ? 1.f / l : 0.f;
    bf16* yo = YA + (rowbase + q) * 512 + h * 64 + 4 * hi;
#pragma unroll
    for (int g = 0; g < 4; ++g) {
        *(GAS v2u*)(yo + 8 * g) = (v2u){pg8::cvt_pk_bf16(o0[4 * g] * inv, o0[4 * g + 1] * inv), pg8::cvt_pk_bf16(o0[4 * g + 2] * inv, o0[4 * g + 3] * inv)};
        *(GAS v2u*)(yo + 32 + 8 * g) = (v2u){pg8::cvt_pk_bf16(o1[4 * g] * inv, o1[4 * g + 1] * inv), pg8::cvt_pk_bf16(o1[4 * g + 2] * inv, o1[4 * g + 3] * inv)};
    }
    if (SAFE) return true;
    __syncthreads();
    return flag[0] == 0u;
}
__device__ __forceinline__ bf16x8v af_join(__attribute__((ext_vector_type(4))) short lo, __attribute__((ext_vector_type(4))) short hi) { return (bf16x8v){lo[0], lo[1], lo[2], lo[3], hi[0], hi[1], hi[2], hi[3]}; }
__device__ __forceinline__ bool attn_unit_fast(LAS unsigned char* lds, const bf16* Q, const bf16* K, const bf16* V, const unsigned* MASK, bf16* YA, int b, int h, int qb, int tid_, int wave, int lane_) {
    int tid = tid_, lane = lane_; asm volatile("" : "+v"(tid), "+v"(lane));
    const int r = lane & 31, hi = lane >> 5;
    const int skey = tid >> 3, sch = tid & 7;
    LAS unsigned char* kw = lds + skey * AT_P + sch * 16;
    LAS unsigned char* vw = lds + AT_VOFF + skey * AT_P + sch * 16;
    const LAS unsigned char* krd = lds + r * AT_P + 16 * hi;
    LAS unsigned char* vrd = lds + AT_VOFF + (4 * hi + ((lane & 15) >> 2)) * AT_P + (16 * ((lane >> 4) & 1) + 4 * (lane & 3)) * 2;
    LAS unsigned* flag = (LAS unsigned*)(lds + AT_VOFF + 2 * AT_BUF);
    const int ntile = 4 * (qb + 1);
    const size_t rowbase = (size_t)b * SEQ;
    const int q = qb * 256 + wave * 32 + r;
    bf16x8v qf[4];
#pragma unroll
    for (int ks = 0; ks < 4; ++ks) qf[ks] = *(const GAS bf16x8v*)(Q + (rowbase + q) * 512 + h * 64 + 16 * ks + 8 * hi);
    const GAS unsigned* mrow = (const GAS unsigned*)MASK + (rowbase + q) * 128;
    const bf16* kg = K + (rowbase + skey) * 512 + h * 64 + sch * 8;
    const bf16* vg = V + (rowbase + skey) * 512 + h * 64 + sch * 8;
    float lsum = 0.f;
    f32x16 o0, o1, a0, a1, b0, b1;
#pragma unroll
    for (int i = 0; i < 16; ++i) { o0[i] = 0.f; o1[i] = 0.f; a0[i] = 0.f; a1[i] = 0.f; b0[i] = 0.f; b1[i] = 0.f; }
#define AF_SB() __builtin_amdgcn_sched_barrier(0)
#define AF_WRITE_V(slot_, reg_) do { *(LAS v4u*)(vw + (slot_) * AT_BUF) = reg_; } while (0)
    typedef short v4s16 __attribute__((ext_vector_type(4)));
#define AF_TR(p_) __builtin_amdgcn_ds_read_tr16_b64_v4i16((LAS v4s16*)(p_))
#define AF_VFRAG(vb__, kk_) af_join(AF_TR((vb__) + (32 * (((kk_) >> 1) >> 1) + 16 * (((kk_) >> 1) & 1)) * AT_P + 64 * ((kk_) & 1)), AF_TR((vb__) + (32 * (((kk_) >> 1) >> 1) + 16 * (((kk_) >> 1) & 1) + 8) * AT_P + 64 * ((kk_) & 1)))
#define AF_EXPM(X, i_, w_) X[i_] = and_bits(__builtin_amdgcn_exp2f(X[i_]), __builtin_amdgcn_sbfe(w_, 8 * ((i_) >> 2) + ((i_) & 3), 1))
    { const v4u kreg = *(const GAS v4u*)kg, vreg = *(const GAS v4u*)vg, kreg1 = *(const GAS v4u*)(kg + (size_t)64 * 512);
      __syncthreads();
      if (tid == 0) flag[0] = 0u;
      *(LAS v4u*)kw = kreg; *(LAS v4u*)(kw + AT_BUF) = kreg1;
      AF_WRITE_V(0, vreg); }
    v2u mw = *(const GAS v2u*)mrow;
    __syncthreads();
    {
#pragma unroll
        for (int ks = 0; ks < 4; ++ks) { const bf16x8v k0 = *(const LAS bf16x8v*)(krd + 32 * ks), k1 = *(const LAS bf16x8v*)(krd + 32 * AT_P + 32 * ks);
            a0 = MFMA32(k0, qf[ks], a0); a1 = MFMA32(k1, qf[ks], a1); }
        const int w0 = (int)(mw.x >> (4 * hi)), w1 = (int)(mw.y >> (4 * hi));
#pragma unroll
        for (int i = 0; i < 16; ++i) { AF_EXPM(a0, i, w0); AF_EXPM(a1, i, w1); }
        mw = *(const GAS v2u*)(mrow + 2);
        LDS_WAIT(); __syncthreads();
    }
#define AF_PV_(P0, P1, v_) ((v_) < 16 ? P0[(v_) & 15] : P1[(v_) & 15])
#define AF_STEP(C0, C1, P0, P1, t_, KY, VY, MY, KX, VX, MX) do {     \
        const int cur = (t_) & 1, tk2 = (t_) + 2 < ntile ? (t_) + 2 : ntile - 1, tv1 = (t_) + 1 < ntile ? (t_) + 1 : ntile - 1; \
        KX = *(const GAS v4u*)(kg + (size_t)tk2 * 64 * 512); VX = *(const GAS v4u*)(vg + (size_t)tv1 * 64 * 512); \
        MX = *(const GAS v2u*)(mrow + tk2 * 2); \
        const LAS unsigned char* kb_ = krd + cur * AT_BUF; LAS unsigned char* vb_ = vrd + (cur ^ 1) * AT_BUF; \
        bf16x8v kf[8], vf[8]; v4u pw[4]; \
        _Pragma("unroll") for (int k_ = 0; k_ < 2; ++k_) kf[k_] = *(const LAS bf16x8v*)(kb_ + (k_ & 1) * 32 * AT_P + 32 * (k_ >> 1));     \
        AF_SB(); \
        _Pragma("unroll") for (int k_ = 0; k_ < 8; ++k_) {     \
            if (k_ + 2 < 8) kf[k_ + 2] = *(const LAS bf16x8v*)(kb_ + ((k_ + 2) & 1) * 32 * AT_P + 32 * ((k_ + 2) >> 1)); \
            if ((k_ & 1) == 0) C0 = MFMA32(kf[k_], qf[k_ >> 1], C0); else C1 = MFMA32(kf[k_], qf[k_ >> 1], C1); \
            const float v0_ = AF_PV_(P0, P1, 4 * k_), v1_ = AF_PV_(P0, P1, 4 * k_ + 1), v2_ = AF_PV_(P0, P1, 4 * k_ + 2), v3_ = AF_PV_(P0, P1, 4 * k_ + 3); \
            lsum += (v0_ + v1_) + (v2_ + v3_); \
            if ((k_ & 1) == 0) { pw[k_ >> 1].x = pg8::cvt_pk_bf16(v0_, v1_); pw[k_ >> 1].y = pg8::cvt_pk_bf16(v2_, v3_); } else { pw[k_ >> 1].z = pg8::cvt_pk_bf16(v0_, v1_); pw[k_ >> 1].w = pg8::cvt_pk_bf16(v2_, v3_); } \
            if (k_ >= 6) vf[k_ - 6] = AF_VFRAG(vb_, k_ - 6); \
            AF_SB(); } \
        const int w0_ = (int)(mw.x >> (4 * hi)), w1_ = (int)(mw.y >> (4 * hi)); \
        _Pragma("unroll") for (int k_ = 0; k_ < 8; ++k_) {     \
            if (k_ + 2 < 8) vf[k_ + 2] = AF_VFRAG(vb_, k_ + 2); \
            if ((k_ & 1) == 0) o0 = MFMA32(vf[k_], __builtin_bit_cast(bf16x8v, pw[k_ >> 1]), o0); else o1 = MFMA32(vf[k_], __builtin_bit_cast(bf16x8v, pw[k_ >> 1]), o1); \
            if (k_ < 4) { AF_EXPM(C0, 4 * k_, w0_); AF_EXPM(C0, 4 * k_ + 1, w0_); AF_EXPM(C0, 4 * k_ + 2, w0_); AF_EXPM(C0, 4 * k_ + 3, w0_); } \
            else { AF_EXPM(C1, 4 * k_ - 16, w1_); AF_EXPM(C1, 4 * k_ - 15, w1_); AF_EXPM(C1, 4 * k_ - 14, w1_); AF_EXPM(C1, 4 * k_ - 13, w1_); } \
            AF_SB(); } \
        if ((t_) + 1 < ntile) *(LAS v4u*)(kw + (cur ^ 1) * AT_BUF) = KY; \
        AF_WRITE_V(cur, VY); mw = MY; \
        _Pragma("unroll") for (int i_ = 0; i_ < 16; ++i_) { P0[i_] = 0.f; P1[i_] = 0.f; }     \
        asm volatile("s_waitcnt lgkmcnt(0)\n\ts_barrier" ::: "memory");     \
        } while (0)
    v4u kn1 = *(const GAS v4u*)(kg + (size_t)2 * 64 * 512), vn1 = *(const GAS v4u*)(vg + (size_t)1 * 64 * 512), kn2 = kn1, vn2 = vn1;
    v2u mn1 = *(const GAS v2u*)(mrow + 4), mn2 = mn1;
    int t = 1;
#pragma unroll 1
    for (; t + 1 < ntile; t += 2) { AF_STEP(b0, b1, a0, a1, t, kn1, vn1, mn1, kn2, vn2, mn2); AF_STEP(a0, a1, b0, b1, t + 1, kn2, vn2, mn2, kn1, vn1, mn1); }
    AF_STEP(b0, b1, a0, a1, t, kn1, vn1, mn1, kn2, vn2, mn2);
    asm volatile("s_waitcnt vmcnt(0)" ::: "memory");
    { LAS unsigned char* vb_ = vrd + ((ntile - 1) & 1) * AT_BUF;
      float s_ = 0.f;
#pragma unroll
      for (int i = 0; i < 16; ++i) s_ += b0[i] + b1[i];
      lsum += s_;
      const bf16x8v pf_[4] = {pack_frag(b0[0], b0[1], b0[2], b0[3], b0[4], b0[5], b0[6], b0[7]), pack_frag(b0[8], b0[9], b0[10], b0[11], b0[12], b0[13], b0[14], b0[15]),
                              pack_frag(b1[0], b1[1], b1[2], b1[3], b1[4], b1[5], b1[6], b1[7]), pack_frag(b1[8], b1[9], b1[10], b1[11], b1[12], b1[13], b1[14], b1[15])};
#pragma unroll
      for (int kk = 0; kk < 8; ++kk) { const bf16x8v vfr = AF_VFRAG(vb_, kk); if ((kk & 1) == 0) o0 = MFMA32(vfr, pf_[kk >> 1], o0); else o1 = MFMA32(vfr, pf_[kk >> 1], o1); }
    }
#undef AF_TR
#undef AF_VFRAG
#undef AF_SB
#undef AF_WRITE_V
#undef AF_EXPM
#undef AF_PV_
#undef AF_STEP
    const float l = lsum + __shfl_xor(lsum, 32);
    const bool okl = l > 1e-30f && l < 1e30f;
    if (__any(!okl) && lane == 0) flag[0] = 1u;
    const float inv = okl ? 1.f / l : 0.f;
    bf16* yo = YA + (rowbase + q) * 512 + h * 64 + 4 * hi;
#pragma unroll
    for (int g = 0; g < 4; ++g) {
        *(GAS v2u*)(yo + 8 * g) = (v2u){pg8::cvt_pk_bf16(o0[4 * g] * inv, o0[4 * g + 1] * inv), pg8::cvt_pk_bf16(o0[4 * g + 2] * inv, o0[4 * g + 3] * inv)};
        *(GAS v2u*)(yo + 32 + 8 * g) = (v2u){pg8::cvt_pk_bf16(o1[4 * g] * inv, o1[4 * g + 1] * inv), pg8::cvt_pk_bf16(o1[4 * g + 2] * inv, o1[4 * g + 3] * inv)};
    }
    __syncthreads();
    return flag[0] == 0u;
}
__device__ __forceinline__ void attn_phase(LAS unsigned char* lds, const bf16* Q, const bf16* K, const bf16* V, const unsigned* MASK, bf16* YA, int blk, int G, int tid, int wave, int lane) {
    const int vcu = (G % 8 == 0) ? (blk % 8) * (G / 8) + blk / 8 : blk;
#pragma unroll 1
    for (int pi = vcu; pi < 512; pi += G) {
#pragma unroll 1
        for (int half = 0; half < 2; ++half) {
            const int bh = pi >> 3, ii = pi & 7, qb = half ? 15 - ii : ii, b = bh >> 3, h = bh & 7;
            if (!attn_unit_fast(lds, Q, K, V, MASK, YA, b, h, qb, tid, wave, lane)) attn_unit<true>(lds, Q, K, V, MASK, YA, b, h, qb, tid, wave, lane);
        }
    }
}

constexpr int IX_REC = 2112, IX_B1 = 1024, IX_NEED = 1028, IX_TAU = 1032, IX_CNT = 1036, IX_W = 1040, IX_LIST = 1088, IX_LCAP = 256, IX_FLAG = 64 * IX_REC;
__device__ __forceinline__ unsigned key16_of(float s) { const _Float16 hf = (_Float16)s; const int h = (int)__builtin_bit_cast(short, hf); return (unsigned)(h ^ ((h >> 15) | 0x8000)) & 0xFFFFu; }
__device__ __forceinline__ float ix_relu(float x) { return __builtin_bit_cast(float, __builtin_elementwise_max(__builtin_bit_cast(int, x), 0)); }
#define IX_RELU(x) ix_relu(x)
template <int PASS, bool DIAG>
__device__ __forceinline__ void idx_tile(LAS unsigned char* rec, const bf16x8v (&af)[4][4], const bf16x8v (&bc)[4], unsigned* MASKb, int j, int rg, int kt, int lane) {
    const int n = lane & 31, hi = lane >> 5, s = kt * 32 + n;
    f32x16 accA, accB;
#define IX_CHAIN(dst, rt_) do { _Pragma("unroll") for (int i = 0; i < 16; ++i) dst[i] = 0.f; _Pragma("unroll") for (int ks = 0; ks < 4; ++ks) dst = MFMA32(af[rt_][ks], bc[ks], dst); } while (0)
    IX_CHAIN(accA, 0);
#pragma unroll
    for (int rt = 0; rt < 4; ++rt) {
        if (rt < 3) IX_CHAIN(accB, (rt < 3 ? rt + 1 : 3));
        LAS unsigned char* ra = rec + rt * 4 * IX_REC; LAS unsigned char* rb = ra + 2 * IX_REC;
        const f32x4 wa0 = *(const LAS f32x4*)(ra + IX_W), wa1 = *(const LAS f32x4*)(ra + IX_W + 16), wb0 = *(const LAS f32x4*)(rb + IX_W), wb1 = *(const LAS f32x4*)(rb + IX_W + 16);
        float sa0 = 0.f, sa1 = 0.f, sb0 = 0.f, sb1 = 0.f;
#pragma unroll
        for (int i = 0; i < 4; i += 2) {
            sa0 = __builtin_fmaf(IX_RELU(accA[i]), wa0[i], sa0); sa1 = __builtin_fmaf(IX_RELU(accA[i + 1]), wa0[i + 1], sa1);
            sb0 = __builtin_fmaf(IX_RELU(accA[8 + i]), wb0[i], sb0); sb1 = __builtin_fmaf(IX_RELU(accA[9 + i]), wb0[i + 1], sb1);
            sa0 = __builtin_fmaf(IX_RELU(accA[4 + i]), wa1[i], sa0); sa1 = __builtin_fmaf(IX_RELU(accA[5 + i]), wa1[i + 1], sa1);
            sb0 = __builtin_fmaf(IX_RELU(accA[12 + i]), wb1[i], sb0); sb1 = __builtin_fmaf(IX_RELU(accA[13 + i]), wb1[i + 1], sb1); }
        float sa = sa0 + sa1, sb = sb0 + sb1;
        asm volatile("" : "+v"(sa), "+v"(sb));
        accA = accB;
        const int qa = rg * 16 + 4 * rt + hi, qb = qa + 2;
        const bool va = !DIAG || s <= j * 64 + qa, vb = !DIAG || s <= j * 64 + qb;
        if (PASS == 1) {
            const unsigned ka = key16_of(sa) >> 8, kb = key16_of(sb) >> 8;
            if (va) __hip_atomic_fetch_add((LAS unsigned*)(ra + ka * 4), 1u, __ATOMIC_RELAXED, __HIP_MEMORY_SCOPE_WORKGROUP);
            if (vb) __hip_atomic_fetch_add((LAS unsigned*)(rb + kb * 4), 1u, __ATOMIC_RELAXED, __HIP_MEMORY_SCOPE_WORKGROUP);
        } else if (PASS == 2) {
            const unsigned ka = key16_of(sa), kb = key16_of(sb);
            const unsigned b1a = *(const LAS unsigned*)(ra + IX_B1), b1b = *(const LAS unsigned*)(rb + IX_B1);
            bool sela = va & ((ka >> 8) > b1a), selb = vb & ((kb >> 8) > b1b);
            if (va && (ka >> 8) == b1a) { __hip_atomic_fetch_add((LAS unsigned*)(ra + (ka & 255u) * 4), 1u, __ATOMIC_RELAXED, __HIP_MEMORY_SCOPE_WORKGROUP);
                const unsigned slot = __hip_atomic_fetch_add((LAS unsigned*)(ra + IX_CNT), 1u, __ATOMIC_RELAXED, __HIP_MEMORY_SCOPE_WORKGROUP);
                if (slot < (unsigned)IX_LCAP) *(LAS unsigned*)(ra + IX_LIST + slot * 4) = ((unsigned)s << 8) | (ka & 255u); else sela = true; }
            if (vb && (kb >> 8) == b1b) { __hip_atomic_fetch_add((LAS unsigned*)(rb + (kb & 255u) * 4), 1u, __ATOMIC_RELAXED, __HIP_MEMORY_SCOPE_WORKGROUP);
                const unsigned slot = __hip_atomic_fetch_add((LAS unsigned*)(rb + IX_CNT), 1u, __ATOMIC_RELAXED, __HIP_MEMORY_SCOPE_WORKGROUP);
                if (slot < (unsigned)IX_LCAP) *(LAS unsigned*)(rb + IX_LIST + slot * 4) = ((unsigned)s << 8) | (kb & 255u); else selb = true; }
            const unsigned long long ba = __ballot(sela), bb = __ballot(selb);
            if (lane == 0) {
                unsigned* mr = MASKb + (size_t)(j * 64 + rg * 16 + 4 * rt) * 128 + kt;
                mr[0] = (unsigned)ba; mr[128] = (unsigned)(ba >> 32); mr[256] = (unsigned)bb; mr[384] = (unsigned)(bb >> 32);
            }
        } else {
            const unsigned long long ba = __ballot(va & ((_Float16)sa >= *(const LAS _Float16*)(ra + IX_TAU))), bb = __ballot(vb & ((_Float16)sb >= *(const LAS _Float16*)(rb + IX_TAU)));
            if (lane == 0) {
                unsigned* mr = MASKb + (size_t)(j * 64 + rg * 16 + 4 * rt) * 128 + kt;
                mr[0] = (unsigned)ba; mr[128] = (unsigned)(ba >> 32); mr[256] = (unsigned)bb; mr[384] = (unsigned)(bb >> 32);
            }
        }
    }
#undef IX_CHAIN
}
template <int PASS>
__device__ __forceinline__ void idx_pass(LAS unsigned char* lds, const bf16x8v (&af)[4][4], const bf16* KIb, unsigned* MASKb, int j, int rg, int kh, int lane) {
    const int n = lane & 31, hi = lane >> 5;
    LAS unsigned char* rec = lds + (rg * 16 + hi) * IX_REC;
    bf16x8v bc[4], bn[4];
    int kt = kh;
#pragma unroll
    for (int ks = 0; ks < 4; ++ks) bc[ks] = *(const GAS bf16x8v*)(KIb + (size_t)(kt * 32 + n) * 64 + 16 * ks + 8 * hi);
#pragma unroll 1
    for (; kt < 2 * j; kt += 2) {
#pragma unroll
        for (int ks = 0; ks < 4; ++ks) bn[ks] = *(const GAS bf16x8v*)(KIb + (size_t)((kt + 2) * 32 + n) * 64 + 16 * ks + 8 * hi);
        idx_tile<PASS, false>(rec, af, bc, MASKb, j, rg, kt, lane);
#pragma unroll
        for (int ks = 0; ks < 4; ++ks) bc[ks] = bn[ks];
    }
    idx_tile<PASS, true>(rec, af, bc, MASKb, j, rg, kt, lane);
}
template <int LEVEL>
__device__ __forceinline__ void idx_scan(LAS unsigned char* lds, int wave, int lane) {
#pragma unroll 4
    for (int qq = 0; qq < 8; ++qq) {
        LAS unsigned char* rq = lds + (wave * 8 + qq) * IX_REC;
        const v4u hc = *(const LAS v4u*)(rq + 16 * lane);
        const unsigned cn[4] = {hc.x, hc.y, hc.z, hc.w};
        const unsigned need = LEVEL == 1 ? 256u : *(const LAS unsigned*)(rq + IX_NEED);
        const unsigned tot = cn[0] + cn[1] + cn[2] + cn[3];
        unsigned incl = tot;
#pragma unroll
        for (int o = 1; o < 64; o <<= 1) { const unsigned v = (unsigned)__shfl_down((int)incl, o); if (lane + o < 64) incl += v; }
        unsigned r = incl - tot; int found = -1; unsigned above = 0u;
#pragma unroll
        for (int k = 3; k >= 0; --k) { if (found < 0 && r < need && r + cn[k] >= need) { found = 4 * lane + k; above = r; } r += cn[k]; }
        if (found >= 0) {
            if (LEVEL == 1) { *(LAS unsigned*)(rq + IX_B1) = (unsigned)found; *(LAS unsigned*)(rq + IX_NEED) = need - above; }
            else { const unsigned key = (*(const LAS unsigned*)(rq + IX_B1) << 8) | (unsigned)found, hb = (key & 0x8000u) ? (key & 0x7FFFu) : (~key & 0xFFFFu);
                   *(LAS _Float16*)(rq + IX_TAU) = __builtin_bit_cast(_Float16, (unsigned short)hb); *(LAS unsigned*)(rq + IX_NEED) = (unsigned)found; }
        }
    }
}
__device__ __forceinline__ void idx_fixup(LAS unsigned char* lds, unsigned* MASKb, int j, int wave, int lane) {
#pragma unroll 1
    for (int qq = 0; qq < 8; ++qq) {
        const int ql = wave * 8 + qq; LAS unsigned char* rq = lds + ql * IX_REC;
        const unsigned cnt0 = *(const LAS unsigned*)(rq + IX_CNT), cnt = cnt0 < (unsigned)IX_LCAP ? cnt0 : (unsigned)IX_LCAP, b2 = *(const LAS unsigned*)(rq + IX_NEED);
        unsigned* mrow = MASKb + (size_t)(j * 64 + ql) * 128;
        for (unsigned e = lane; e < cnt; e += 64) { const unsigned en = *(const LAS unsigned*)(rq + IX_LIST + e * 4), sidx = en >> 8;
            if ((en & 255u) >= b2) __hip_atomic_fetch_or(mrow + (sidx >> 5), 1u << (sidx & 31u), __ATOMIC_RELAXED, __HIP_MEMORY_SCOPE_AGENT); }
    }
}
__device__ __forceinline__ void index_phase(LAS unsigned char* lds, const bf16* QI, const bf16* KI, const float* WI, unsigned* MASK, int blk, int G, int tid, int wave, int lane) {
    const int rg = wave >> 1, kh = wave & 1, r = lane & 31, hi = lane >> 5;
    const int qsr = 2 * (r >> 4) + ((r >> 2) & 1), hdr = (r & 3) + 4 * ((r >> 3) & 1);
#pragma unroll 1
    for (int p = blk; p < 256; p += G) {
#pragma unroll 1
        for (int half = 0; half < 2; ++half) {
            const int b = p >> 5, jj = p & 31, j = half ? 63 - jj : jj;
            const size_t rowbase = (size_t)b * SEQ;
            unsigned* MASKb = MASK + rowbase * 128;
            if (j < 4) {
                const int row = tid >> 3, t = j * 64 + row;
#pragma unroll 4
                for (int k = 0; k < 16; ++k) { const int w = (tid & 7) * 16 + k, d = t - 32 * w; MASKb[(size_t)t * 128 + w] = d >= 31 ? 0xFFFFFFFFu : d < 0 ? 0u : ((2u << d) - 1u); }
                continue;
            }
            bf16x8v af[4][4];
#pragma unroll
            for (int rt = 0; rt < 4; ++rt) {
                const size_t tq = rowbase + j * 64 + rg * 16 + 4 * rt + qsr;
#pragma unroll
                for (int ks = 0; ks < 4; ++ks) af[rt][ks] = *(const GAS bf16x8v*)(QI + tq * 512 + hdr * 64 + 16 * ks + 8 * hi);
            }
            const float wmine = WI[(rowbase + j * 64) * 8 + tid];
            const bf16* KIb = KI + rowbase * 64;
            __syncthreads();
            *(LAS float*)(lds + (tid >> 3) * IX_REC + IX_W + (tid & 7) * 4) = wmine;
#pragma unroll
            for (int k = 0; k < 8; ++k) *(LAS v4u*)(lds + (tid >> 3) * IX_REC + (tid & 7) * 128 + k * 16) = (v4u){0u, 0u, 0u, 0u};
            __syncthreads();
            idx_pass<1>(lds, af, KIb, MASKb, j, rg, kh, lane);
            __syncthreads();
            idx_scan<1>(lds, wave, lane);
            __syncthreads();
#pragma unroll
            for (int k = 0; k < 8; ++k) *(LAS v4u*)(lds + (tid >> 3) * IX_REC + (tid & 7) * 128 + k * 16) = (v4u){0u, 0u, 0u, 0u};
            if ((tid & 7) == 0) *(LAS unsigned*)(lds + (tid >> 3) * IX_REC + IX_CNT) = 0u;
            __syncthreads();
            idx_pass<2>(lds, af, KIb, MASKb, j, rg, kh, lane);
            asm volatile("s_waitcnt vmcnt(0)" ::: "memory");
            __syncthreads();
            idx_scan<2>(lds, wave, lane);
            __syncthreads();
            idx_fixup(lds, MASKb, j, wave, lane);
            { const int row = tid >> 3, t = j * 64 + row;
              for (int w = 2 * (j + 1) + (tid & 7); w < 128; w += 8) MASKb[(size_t)t * 128 + w] = 0u; }
        }
    }
}

constexpr int LR_WAVE = 16384, LR_AOFF = 8192, LR_XP = 144;
template <int PASS>
__device__ __forceinline__ void lru_phase(LAS unsigned char* lds, int layer, const bf16* XR, const bf16* GR, float* AGG, bf16* YB, int blk, int G, int wave, int lane) {
    const int hb = wave, c = hb * 64 + lane, n = lane & 31, hi = lane >> 5;
    LAS float* xib = (LAS float*)(lds + wave * LR_WAVE);
    LAS float* abuf = (LAS float*)(lds + wave * LR_WAVE + LR_AOFF);
    LAS unsigned char* xcb = lds + wave * LR_WAVE + LR_AOFF;
    bf16x8v wf[2][2][4];
    { const float* w_a = kin(7) + (size_t)(layer * 8 + hb) * 4096; const float* w_x = kin(9) + (size_t)(layer * 8 + hb) * 4096;
#pragma unroll
      for (int nt = 0; nt < 2; ++nt)
#pragma unroll
        for (int ks = 0; ks < 4; ++ks) { float a[8], x[8];
#pragma unroll
            for (int jj = 0; jj < 8; ++jj) { const int idx = (16 * ks + 8 * hi + jj) * 64 + 32 * nt + n; a[jj] = w_a[idx]; x[jj] = w_x[idx]; }
            wf[0][nt][ks] = pack_frag(a[0], a[1], a[2], a[3], a[4], a[5], a[6], a[7]); wf[1][nt][ks] = pack_frag(x[0], x[1], x[2], x[3], x[4], x[5], x[6], x[7]); } }
    const float* cwp = kin(5);
    const float cw0 = cwp[(layer * 4 + 0) * 512 + c], cw1 = cwp[(layer * 4 + 1) * 512 + c], cw2 = cwp[(layer * 4 + 2) * 512 + c], cw3 = cwp[(layer * 4 + 3) * 512 + c];
    const float cb = kin(6)[layer * 512 + c];
    float ba[2], bx[2], sp8[2];
#pragma unroll
    for (int nt = 0; nt < 2; ++nt) { const int ce = layer * 512 + hb * 64 + 32 * nt + n; ba[nt] = kin(8)[ce]; bx[nt] = kin(10)[ce];
        const float lam = kin(11)[ce]; sp8[nt] = 8.f * (fmaxf(-lam, 0.f) + log1pf(__expf(-fabsf(lam)))); }
#pragma unroll 1
    for (int u = blk; u < NB * 32; u += G) {
        const int b = u >> 5, ch = u & 31, row0 = b * SEQ + ch * 128;
        float x0 = 0.f, x1 = 0.f, x2 = 0.f;
        if (ch > 0) { x0 = bf2f(XR[(size_t)(row0 - 3) * 512 + c]); x1 = bf2f(XR[(size_t)(row0 - 2) * 512 + c]); x2 = bf2f(XR[(size_t)(row0 - 1) * 512 + c]); }
        float h = 0.f, P = 1.f;
        if (PASS == 2) {
#pragma unroll 1
            for (int j0 = 0; j0 < ch; j0 += 8) { f32x2 ag[8];
#pragma unroll
                for (int k = 0; k < 8; ++k) ag[k] = j0 + k < ch ? *(const GAS f32x2*)(AGG + ((size_t)(b * 32 + j0 + k) * 512 + c) * 2) : (f32x2){1.f, 0.f};
#pragma unroll
                for (int k = 0; k < 8; ++k) h = ag[k][0] * h + ag[k][1]; } }
#pragma unroll 1
        for (int sc = 0; sc < 4; ++sc) {
            const int r0 = row0 + sc * 32;
#pragma unroll 1
            for (int th = 0; th < 32; th += 16) {
            float xin[16];
#pragma unroll
            for (int t = 0; t < 16; ++t) xin[t] = bf2f(XR[(size_t)(r0 + th + t) * 512 + c]);
#pragma unroll
            for (int tl = 0; tl < 16; ++tl) {
                const int t = th + tl;
                const float xt = xin[tl];
                const float xc = cw0 * x0 + cw1 * x1 + cw2 * x2 + cw3 * xt + cb;
                x0 = x1; x1 = x2; x2 = xt;
                xib[t * 64 + lane] = xc;
                *(LAS unsigned short*)(xcb + t * LR_XP + lane * 2) = (unsigned short)f2bf(xc);
            } }
            LDS_WAIT();
            bf16x8v af[4];
#pragma unroll
            for (int ks = 0; ks < 4; ++ks) af[ks] = *(const LAS bf16x8v*)(xcb + n * LR_XP + (16 * ks + 8 * hi) * 2);
            LDS_WAIT();
            f32x16 ga[2], gx[2];
#pragma unroll
            for (int nt = 0; nt < 2; ++nt) {
#pragma unroll
                for (int i = 0; i < 16; ++i) { ga[nt][i] = 0.f; gx[nt][i] = 0.f; }
#pragma unroll
                for (int ks = 0; ks < 4; ++ks) { ga[nt] = MFMA32(af[ks], wf[0][nt][ks], ga[nt]); gx[nt] = MFMA32(af[ks], wf[1][nt][ks], gx[nt]); } }
#pragma unroll
            for (int nt = 0; nt < 2; ++nt)
#pragma unroll
                for (int i = 0; i < 16; ++i) { const int tt = 8 * (i >> 2) + 4 * hi + (i & 3), li = tt * 64 + 32 * nt + n;
                    const float r = sigm(ga[nt][i] + ba[nt]), ig = sigm(gx[nt][i] + bx[nt]);
                    const float la = -sp8[nt] * r, a = pg8::fexp(la), y = 2.f * la;
                    const float em = -y * (1.f + y * (0.5f + y * (0.16666667f + y * (0.041666668f + y * (0.0083333338f + y * (0.0013888889f + y * 0.0001984127f))))));
                    const float xc = xib[li];
                    const float em2 = y > -0.25f ? em : 1.f - a * a;
                    abuf[li] = a; xib[li] = __builtin_amdgcn_sqrtf(fmaxf(em2, 0.f)) * (ig * xc); }
            LDS_WAIT();
#pragma unroll 1
            for (int th = 0; th < 32; th += 16) {
                float gin[16];
                if (PASS == 2) {
#pragma unroll
                    for (int t = 0; t < 16; ++t) gin[t] = bf2f(GR[(size_t)(r0 + th + t) * 512 + c]); }
#pragma unroll
                for (int t = 0; t < 16; ++t) {
                    const float a = abuf[(th + t) * 64 + lane], in = xib[(th + t) * 64 + lane];
                    h = a * h + in; P *= a;
                    if (PASS == 2) YB[(size_t)(r0 + th + t) * 512 + c] = (bf16)f2bf(h * gin[t]);
                }
            }
            LDS_WAIT();
        }
        if (PASS == 1) *(GAS f32x2*)(AGG + ((size_t)u * 512 + c) * 2) = (f32x2){P, h};
    }
}

constexpr int GM_RMS = 0, GM_IMG = 512, GM_P = 272, GM_WAVE = 64 * GM_P;
__device__ __forceinline__ void gmlp_phase(LAS unsigned char* lds, int layer, const bf16* ZU, const bf16* ZV, bf16* YC, int blk, int G, int tid, int wave, int lane) {
    LAS float* rms = (LAS float*)(lds + GM_RMS);
    LAS unsigned char* img = lds + GM_IMG + wave * GM_WAVE;
    const int g = wave, n = lane & 31, hi = lane >> 5;
    const float* wsp = kin(13) + (size_t)(layer * 8 + g) * 128 * 128;
    const float* bsp = kin(14) + (size_t)(layer * 8 + g) * 128;
    const int wch = lane & 7, wtk = lane >> 3;
    float gv[8];
#pragma unroll
    for (int i = 0; i < 8; ++i) gv[i] = kin(12)[layer * 512 + g * 64 + wch * 8 + i];
#pragma unroll 1
    for (int u = blk; u < NB * 32; u += G) {
        const int row0 = u * 128;
        __syncthreads();
        { v4u zr[16];
#pragma unroll
          for (int i = 0; i < 16; ++i) zr[i] = *(const GAS v4u*)(ZV + (size_t)(row0 + wave * 16 + i) * 512 + lane * 8);
          float mine = 0.f;
#pragma unroll
          for (int i = 0; i < 16; ++i) { float a[8]; unpack8(zr[i], a); float ss = 0.f;
#pragma unroll
              for (int k = 0; k < 8; ++k) ss += a[k] * a[k];
              ss = wave_sum(ss);
              if (lane == i) mine = ss; }
          if (lane < 16) rms[wave * 16 + lane] = 1.f / sqrtf(mine * (1.f / 512.f) + EPS); }
        __syncthreads();
        v4u zi[16];
#pragma unroll
        for (int i = 0; i < 16; ++i) zi[i] = *(const GAS v4u*)(ZV + (size_t)(row0 + i * 8 + wtk) * 512 + g * 64 + wch * 8);
#pragma unroll
        for (int i = 0; i < 16; ++i) { const int s = i * 8 + wtk; float a[8]; unpack8(zi[i], a);
            const float rs = rms[s];
#pragma unroll
            for (int k = 0; k < 8; ++k) *(LAS unsigned short*)(img + (wch * 8 + k) * GM_P + s * 2) = (unsigned short)f2bf(a[k] * rs * gv[k]); }
        LDS_WAIT();
#pragma unroll
        for (int mt = 0; mt < 4; ++mt) {
            f32x16 acc[2];
#pragma unroll
            for (int i = 0; i < 16; ++i) { acc[0][i] = 0.f; acc[1][i] = 0.f; }
            const int t = 32 * mt + n;
#pragma unroll
            for (int ks = 0; ks < 2 * (mt + 1); ++ks) {
                const int s0 = 16 * ks + 8 * hi;
                const f32x4 wa = *(const GAS f32x4*)(wsp + t * 128 + s0), wb = *(const GAS f32x4*)(wsp + t * 128 + s0 + 4);
                float w[8] = {wa[0], wa[1], wa[2], wa[3], wb[0], wb[1], wb[2], wb[3]};
                if (ks >= 2 * mt) {
#pragma unroll
                    for (int k = 0; k < 8; ++k) w[k] = (s0 + k <= t) ? w[k] : 0.f; }
                const bf16x8v af = pack_frag(w[0], w[1], w[2], w[3], w[4], w[5], w[6], w[7]);
#pragma unroll
                for (int nt = 0; nt < 2; ++nt) { const bf16x8v bfr = *(const LAS bf16x8v*)(img + (32 * nt + n) * GM_P + s0 * 2); acc[nt] = MFMA32(af, bfr, acc[nt]); }
            }
#pragma unroll
            for (int i = 0; i < 16; ++i) { const int tt = 32 * mt + 8 * (i >> 2) + 4 * hi + (i & 3); const float bs = bsp[tt];
#pragma unroll
                for (int nt = 0; nt < 2; ++nt) { const size_t o = (size_t)(row0 + tt) * 512 + g * 64 + 32 * nt + n;
                    YC[o] = (bf16)f2bf(bf2f(ZU[o]) * (acc[nt][i] + bs)); } }
        }
    }
}

#define IN(k) (lo <= (k) && (k) < hi)
#ifndef REP_B
#define REP_B 1
#endif
#define SEAM(k) do { if (IN(k) && IN((k) + 1)) { for (int rb_ = 0; rb_ < REP_B; ++rb_) xcd_barrier(bar); } } while (0)
#define WP(T, off) ((T*)(ws + (off)))
#define PH_LOCAL() int G = gridDim.x, blk = blockIdx.x; asm volatile("" : "+s"(G), "+s"(blk)); const int NGW = G * NWAVES; int tid = wave0 * 64 + lane_id(); asm volatile("" : "+v"(tid)); \
    const int lane = tid & 63, wave = __builtin_amdgcn_readfirstlane(tid >> 6), gw = blk * NWAVES + wave; (void)lane; (void)gw; (void)NGW
template <int layer>
__device__ __forceinline__ void layer_body(LAS unsigned char* lds, const XcdBarrier& bar, const int lo, const int hi, const int wave0) {
        const int pb = 1 + layer * PH_PER_LAYER;
#define WL(off) ((const bf16*)(ws + WS_W + (size_t)layer * W_LAYER + (off)))

        if (IN(pb + 0)) {
            unsigned char* ws = kws(); PH_LOCAL();
            pg8::Gemm g{WP(bf16, WS_H), WL(WO_IN), M, NA, D}; pg8::StaticOrder S; S.init(M, NA, G, blk);
            pg8::EpiInA E{WP(bf16, WS_Q), WP(bf16, WS_K), WP(bf16, WS_V), WP(bf16, WS_QI), WP(bf16, WS_XR), WP(bf16, WS_GR), WP(bf16, WS_ZU), WP(bf16, WS_ZV), WP(bf16, WS_KI), WP(float, WS_WI), WP(float, WS_ROPE)};
            for (int rep_ = 0; rep_ < REP_G; ++rep_) { pg8::gemm_phase<pg8::EpiInA, pg8::StaticOrder, true, true>(lds, g, S, E, wave0); }
        }
        SEAM(pb + 0);
        if (IN(pb + 1)) {
            { unsigned char* ws = kws(); PH_LOCAL();
              for (int rep_ = 0; rep_ < REP_I; ++rep_) { index_phase(lds, WP(bf16, WS_QI), WP(bf16, WS_KI), WP(float, WS_WI), WP(unsigned, WS_SEL), blk, G, tid, wave, lane); __syncthreads(); } }
            __syncthreads();
            { unsigned char* ws = kws(); PH_LOCAL();
              for (int rep_ = 0; rep_ < REP_M; ++rep_) { lru_phase<1>(lds, layer, WP(bf16, WS_XR), WP(bf16, WS_GR), WP(float, WS_AGG), WP(bf16, WS_ZU), blk, G, wave, lane); } }
            __syncthreads();
            { unsigned char* ws = kws(); PH_LOCAL();
              for (int rep_ = 0; rep_ < REP_M; ++rep_) { gmlp_phase(lds, layer, WP(bf16, WS_ZU), WP(bf16, WS_ZV), WP(bf16, WS_YC), blk, G, tid, wave, lane); } }
        }
        SEAM(pb + 1);
        if (IN(pb + 2)) {
            __syncthreads();
            { unsigned char* ws = kws(); PH_LOCAL();
              for (int rep_ = 0; rep_ < REP_A; ++rep_) { attn_phase(lds, WP(bf16, WS_Q), WP(bf16, WS_K), WP(bf16, WS_V), WP(unsigned, WS_SEL), WP(bf16, WS_QI), blk, G, tid, wave, lane); __syncthreads(); } }
            __syncthreads();
            { unsigned char* ws = kws(); PH_LOCAL();
              for (int rep_ = 0; rep_ < REP_M; ++rep_) { lru_phase<2>(lds, layer, WP(bf16, WS_XR), WP(bf16, WS_GR), WP(float, WS_AGG), WP(bf16, WS_ZU), blk, G, wave, lane); } }
        }
        SEAM(pb + 2);
        if (IN(pb + 3)) {
            unsigned char* ws = kws(); PH_LOCAL();
            pg8::Gemm g{WP(bf16, WS_H), WL(WO_IN) + (size_t)NA * D, M, NG, D}; pg8::StaticOrder S; S.init(M, NG, G, blk);
            pg8::EpiGen<4> E{WP(bf16, WS_G), NG, nullptr};
            for (int rep_ = 0; rep_ < REP_G; ++rep_) { pg8::gemm_phase<pg8::EpiGen<4>, pg8::StaticOrder, true, true>(lds, g, S, E, wave0); }
        }
        SEAM(pb + 3);
        if (IN(pb + 4)) {
            unsigned char* ws = kws(); PH_LOCAL();
            pg8::Gemm g{WP(bf16, WS_QI), WL(WO_BR), 3 * M, 3 * D, 512}; pg8::MergeOrder S; S.so.init(M, D, G, blk);
            pg8::EpiMerge2 E{WP(bf16, WS_H), WP(bf16, WS_G)};
            for (int rep_ = 0; rep_ < REP_G * REP_MG; ++rep_) { pg8::gemm_phase<pg8::EpiMerge2, pg8::MergeOrder, true, true>(lds, g, S, E, wave0); }
        }
        SEAM(pb + 4);
        if (IN(pb + 5)) {
            unsigned char* ws = kws(); PH_LOCAL();
            pg8::Gemm g{WP(bf16, WS_H), WL(WO_OUT), M, D, D}; pg8::StaticOrder S; S.init(M, D, G, blk);
            pg8::EpiGen<0> E{WP(bf16, WS_T), D, nullptr};
            for (int rep_ = 0; rep_ < REP_G; ++rep_) { pg8::gemm_phase<pg8::EpiGen<0>, pg8::StaticOrder, true, true>(lds, g, S, E, wave0); }
        }
        SEAM(pb + 5);
        if (IN(pb + 6)) { unsigned char* ws = kws(); PH_LOCAL();  _Float16* X = (_Float16*)kout(); if (layer == 0) norm_phase<float, _Float16>(kin(0), X, WP(bf16, WS_T), kin(17) + layer * D, kin(18) + layer * D, WP(bf16, WS_H), 0, gw, NGW, lane);
            else norm_phase<_Float16, _Float16>(X, X, WP(bf16, WS_T), kin(17) + layer * D, kin(18) + layer * D, WP(bf16, WS_H), 0, gw, NGW, lane); }
        SEAM(pb + 6);
        if (IN(pb + 7)) {
            unsigned char* ws = kws(); PH_LOCAL();
            pg8::Gemm g{WP(bf16, WS_H), WL(WO_UP), M, FF, D}; pg8::StaticOrder S; S.init(M, FF, G, blk);
            pg8::EpiGen<1> E{WP(bf16, WS_U), FF, nullptr};
            for (int rep_ = 0; rep_ < REP_G; ++rep_) { pg8::gemm_phase<pg8::EpiGen<1>, pg8::StaticOrder, true, true>(lds, g, S, E, wave0); }
        }
        SEAM(pb + 7);
        if (IN(pb + 8)) {
            unsigned char* ws = kws(); PH_LOCAL();
            pg8::Gemm g{WP(bf16, WS_U), WL(WO_DN), M, D, FF}; pg8::StaticOrder S; S.init(M, D, G, blk);
            pg8::EpiGen<0> E{WP(bf16, WS_T2), D, nullptr};
#ifndef DBG_NOF
            for (int rep_ = 0; rep_ < REP_G; ++rep_) { pg8::gemm_phase<pg8::EpiGen<0>, pg8::StaticOrder, true, true>(lds, g, S, E, wave0); }
#else
            { const int tid = wave0 * 64 + lane_id(); for (size_t e = (size_t)(blk * 512 + tid) * 8; e < (size_t)M * D; e += (size_t)G * 512 * 8) *(GAS v4u*)(WP(bf16, WS_T2) + e) = (v4u){0u, 0u, 0u, 0u}; }
#endif
        }
        SEAM(pb + 8);
        if (IN(pb + 9)) { unsigned char* ws = kws(); PH_LOCAL();  _Float16* X = (_Float16*)kout(); norm_phase<_Float16, _Float16>(X, layer + 1 < NLAYER ? X : WP(_Float16, WS_XPARK), WP(bf16, WS_T2), kin(21) + layer * D, nullptr, WP(bf16, WS_H), 1, gw, NGW, lane); }
        SEAM(pb + 9);
        if (IN(pb + 10)) {
            unsigned char* ws = kws(); PH_LOCAL();
            pg8::Gemm g{WP(bf16, WS_H), WL(WO_PG), M, D, D}; pg8::StaticOrder S; S.init(M, D, G, blk);
#ifdef DBG_S0
            zero_rows(WP(bf16, WS_S), blk, G, wave0 * 64 + lane_id()); zero_rows(WP(bf16, WS_S) + (size_t)M * 512, blk, G, wave0 * 64 + lane_id());
#else
#ifdef DBG_S2T
            pg8::EpiGen<2> E{WP(bf16, WS_T3), D, nullptr};
#else
            pg8::EpiGen<2> E{WP(bf16, WS_S), D, nullptr};
#endif
            for (int rep_ = 0; rep_ < REP_G; ++rep_) { pg8::gemm_phase<pg8::EpiGen<2>, pg8::StaticOrder, true, true>(lds, g, S, E, wave0); }
#endif
        }
        if (IN(pb + 10) && IN(pb + 11)) { asm volatile("s_waitcnt vmcnt(0)" ::: "memory"); __syncthreads(); }
        if (IN(pb + 11)) {
            unsigned char* ws = kws(); PH_LOCAL();
            pg8::Gemm g{WP(bf16, WS_P) + (size_t)layer * M * PLE, WL(WO_PLE), M, D, PLE}; pg8::StaticOrder S; S.init(M, D, G, blk);
#ifdef DBG_S2T
#elif defined(DBG_P0)
            pg8::EpiGen<0> E{WP(bf16, WS_T3), D, WP(bf16, WS_S)};
            for (int rep_ = 0; rep_ < REP_G; ++rep_) { pg8::gemm_phase<pg8::EpiGen<0>, pg8::StaticOrder, true, true>(lds, g, S, E, wave0); }
#elif !defined(DBG_NOP)
            pg8::EpiGen<3> E{WP(bf16, WS_T3), D, WP(bf16, WS_S)};
            for (int rep_ = 0; rep_ < REP_G; ++rep_) { pg8::gemm_phase<pg8::EpiGen<3>, pg8::StaticOrder, true, true>(lds, g, S, E, wave0); }
#else
            { const int tid = wave0 * 64 + lane_id(); for (size_t e = (size_t)(blk * 512 + tid) * 8; e < (size_t)M * D; e += (size_t)G * 512 * 8) *(GAS v4u*)(WP(bf16, WS_T3) + e) = (v4u){0u, 0u, 0u, 0u}; }
#endif
        }
        SEAM(pb + 11);
        if (IN(pb + 12)) {
            unsigned char* ws = kws(); PH_LOCAL();
            if (layer + 1 < NLAYER) { _Float16* X = (_Float16*)kout(); norm_phase<_Float16, _Float16>(X, X, WP(bf16, WS_T3), kin(24) + layer * D, kin(3) + (layer + 1) * D, WP(bf16, WS_H), 0, gw, NGW, lane); }
            else norm_phase<_Float16, float>(WP(_Float16, WS_XPARK), kout(), WP(bf16, WS_T3), kin(24) + layer * D, nullptr, WP(bf16, WS_H), 2, gw, NGW, lane);
        }
        SEAM(pb + 12);
    }

__global__ void __launch_bounds__(NWAVES * 64, 2) fwd(Args args) {
    extern __shared__ __attribute__((aligned(16))) unsigned char lds_raw[];
    LAS unsigned char* lds = (LAS unsigned char*)lds_raw;
    volatile LAS unsigned* MISC = (volatile LAS unsigned*)(lds + MISC_OFF);
    const int wave0 = __builtin_amdgcn_readfirstlane((int)(threadIdx.x >> 6));
    if (wave0 == 0) { const int l = lane_id(); if (l < 32) MISC[l] = 0u; }
    __syncthreads();
    const int lo = args.ph_lo, hi = args.ph_hi;
    XcdBarrier bar; bar.bar = (unsigned*)(kws() + WS_CTL) + CW_BAR; bar.x = 0; bar.st = nullptr; bar.w0 = wave0;
    if (hi - lo > 1) bar = xcd_barrier_post((unsigned*)(kws() + WS_CTL) + CW_BAR, MISC + 8, wave0);

    if (IN(0)) for (int rpp_ = 0; rpp_ < REP_PRO; ++rpp_) {
        unsigned char* ws = kws(); PH_LOCAL();
        LAS float* scr = (LAS float*)(lds + wave * 16384);
        constexpr int I_IN = 16 * (NIN / 32), I_BR = 8 * 32, I_OUT = 16 * 32, I_UP = 16 * 128, I_DN = 64 * 32, I_PLE = 4 * 32, I_PG = 16 * 32;
        constexpr int I_LAYER = I_IN + 3 * I_BR + I_OUT + I_UP + I_DN + I_PLE + I_PG;
        for (int it = gw; it < NLAYER * I_LAYER; it += NGW) {
            const int layer = it / I_LAYER; int r = it % I_LAYER;
            unsigned char* wl = ws + WS_W + (size_t)layer * W_LAYER;
            if (r < I_IN) { transpose_item(kin(4) + (size_t)layer * D * INW, D, INW, (bf16*)(wl + WO_IN), NIN / 32, scr, r, lane, MapIn{}); continue; } r -= I_IN;
            if (r < 3 * I_BR) { const int n = r / I_BR; transpose_item(kin(15) + ((size_t)layer * 3 + n) * 512 * D, 512, D, (bf16*)(wl + WO_BR) + (size_t)n * D * 512, D / 32, scr, r % I_BR, lane, MapIdent{0}); continue; } r -= 3 * I_BR;
            if (r < I_OUT) { transpose_item(kin(16) + (size_t)layer * D * D, D, D, (bf16*)(wl + WO_OUT), D / 32, scr, r, lane, MapIdent{0}); continue; } r -= I_OUT;
            if (r < I_UP) { transpose_item(kin(19) + (size_t)layer * D * FF, D, FF, (bf16*)(wl + WO_UP), FF / 32, scr, r, lane, MapIdent{0}); continue; } r -= I_UP;
            if (r < I_DN) { transpose_item(kin(20) + (size_t)layer * FF * D, FF, D, (bf16*)(wl + WO_DN), D / 32, scr, r, lane, MapIdent{0}); continue; } r -= I_DN;
            if (r < I_PLE) { transpose_item(kin(22) + (size_t)layer * PLE * D, PLE, D, (bf16*)(wl + WO_PLE), D / 32, scr, r, lane, MapIdent{0}); continue; } r -= I_PLE;
            transpose_item(kin(23) + (size_t)layer * D * D, D, D, (bf16*)(wl + WO_PG), D / 32, scr, r, lane, MapIdent{0});
        }
        { const int* pos = (const int*)kin(2); float* rope = WP(float, WS_ROPE);
          for (int e = blk * 512 + tid; e < M * 8; e += G * 512) { const int row = e >> 3, jf = e & 7;
              const float invf = jf == 0 ? 1.0f : jf == 1 ? 0.1939227432012558f : jf == 2 ? 0.03760603070259094f : jf == 3 ? 0.007292664609849453f : jf == 4 ? 0.0014142135623842478f : jf == 5 ? 0.00027424818836152554f : jf == 6 ? 5.318296098266728e-05f : 1.0313386155758053e-05f;
              const float ang = (float)pos[row] * invf; float s, c; sincos_d(ang, s, c);
              *(GAS f32x2*)(rope + (size_t)row * 16 + jf * 2) = (f32x2){c, s}; } }
        { const float* p = kin(1); bf16* Pb = WP(bf16, WS_P);
#pragma unroll 4
          for (size_t e = (size_t)(blk * 512 + tid) * 8; e < (size_t)NLAYER * M * PLE; e += (size_t)G * 512 * 8) {
              const f32x4 a = *(const GAS f32x4*)(p + e), b2 = *(const GAS f32x4*)(p + e + 4);
              const float o[8] = {a[0], a[1], a[2], a[3], b2[0], b2[1], b2[2], b2[3]};
              *(GAS v4u*)(Pb + e) = pack8(o); } }
        norm_phase<float, float>(kin(0), nullptr, nullptr, nullptr, kin(3), WP(bf16, WS_H), 0, gw, NGW, lane);
    }
    SEAM(0);

    layer_body<0>(lds, bar, lo, hi, wave0);
    layer_body<1>(lds, bar, lo, hi, wave0);
#undef IN
#undef SEAM
}

extern "C" void kernel_launch(void* const* d_in, const int* in_sizes, int n_in, void* d_out, int out_size, void* d_ws, size_t ws_size, hipStream_t stream) {
    static int grid = 0;
    if (grid == 0) {
        if (n_in != 25 || in_sizes[0] != M * D || out_size != M * D || ws_size < WS_END) { fprintf(stderr, "kernel_launch: unexpected shapes: n_in %d in0 %d out %d ws %zu (need %zu)\n", n_in, n_in > 0 ? in_sizes[0] : -1, out_size, ws_size, (size_t)WS_END); grid = -1; return; }
        int dev = 0, cus = 0, per_cu = 0;
        if (hipGetDevice(&dev) != hipSuccess || hipDeviceGetAttribute(&cus, hipDeviceAttributeMultiprocessorCount, dev) != hipSuccess) { grid = -1; return; }
        if (hipFuncSetAttribute((const void*)fwd, hipFuncAttributeMaxDynamicSharedMemorySize, LDS_BYTES) != hipSuccess) { fprintf(stderr, "kernel_launch: hipFuncSetAttribute failed\n"); grid = -1; return; }
        if (hipOccupancyMaxActiveBlocksPerMultiprocessor(&per_cu, (const void*)fwd, NWAVES * 64, LDS_BYTES) != hipSuccess || per_cu < 1) { fprintf(stderr, "kernel_launch: occupancy query reports %d\n", per_cu); }
        (void)hipGetLastError();
        grid = cus;
    }
    if (grid < 0) return;
    if (hipMemsetAsync((char*)d_ws + WS_CTL, 0, CTL_ZERO_BYTES, stream) != hipSuccess) return;
    Args a{};
    for (int i = 0; i < 25; ++i) a.in[i] = (const float*)d_in[i];
    a.out = (float*)d_out; a.ws = (unsigned char*)d_ws;
#if MK_ONE_LAUNCH
    a.ph_lo = 0; a.ph_hi = NPH;
    hipLaunchKernelGGL(fwd, dim3(grid), dim3(NWAVES * 64), LDS_BYTES, stream, a);
#else
    for (int ph = 0; ph < NPH; ++ph) { a.ph_lo = ph; a.ph_hi = ph + 1; hipLaunchKernelGGL(fwd, dim3(grid), dim3(NWAVES * 64), LDS_BYTES, stream, a); }
#endif
}
```
